# Optimizing an MI355X kernel written in HIP

```python
import jax, jax.numpy as jnp
from jax import lax
import numpy as np

D_MODEL = 4096
BATCH = 4
SEQ = 2048
DEPTH = 1

CHUNK = 64
N_LEFT_CHUNKS = 8
BAND = N_LEFT_CHUNKS + 1
A_WIDTH = D_MODEL // 2
A_HEAD_DIM = 128
A_HEADS = A_WIDTH // A_HEAD_DIM
REL_MAX = 128
REL_SIZE = REL_MAX + CHUNK
B_WIDTH = D_MODEL - A_WIDTH
POOL_WINDOWS = (2, 4, 8, 16)
B_GROUPS = len(POOL_WINDOWS)
B_GROUP_DIM = B_WIDTH // B_GROUPS
MIX_WIDTH = A_WIDTH + B_WIDTH
IN_COLS = 4 * A_WIDTH + 2 * B_WIDTH
XA_HEADS = 4
XA_HEAD_DIM = D_MODEL // 16
XA_WIDTH = XA_HEADS * XA_HEAD_DIM
N_MEM = 256
EPS = 1e-6
NEG_INF = -1e30

kernel_name = "hybrid_chunked_attn_multiscale_pool_block"


def rmsnorm(x, g):
    xf = x.astype(jnp.float32)
    y = xf * lax.rsqrt(jnp.mean(xf * xf, axis=-1, keepdims=True) + EPS)
    return (y * g.astype(jnp.float32)).astype(x.dtype)


def chunked_rel_attention(q, k, v, rel_bias):
    b, s, h, dh = q.shape
    nc = s // CHUNK
    qc = (q * (dh ** -0.5)).reshape(b, nc, CHUNK, h, dh)
    pad = ((0, 0), (N_LEFT_CHUNKS * CHUNK, 0), (0, 0), (0, 0))
    kp = jnp.pad(k, pad).reshape(b, nc + N_LEFT_CHUNKS, CHUNK, h, dh)
    vp = jnp.pad(v, pad).reshape(b, nc + N_LEFT_CHUNKS, CHUNK, h, dh)
    band_idx = jnp.arange(nc)[:, None] + jnp.arange(BAND)[None, :]
    kb = kp[:, band_idx].reshape(b, nc, BAND * CHUNK, h, dh)
    vb = vp[:, band_idx].reshape(b, nc, BAND * CHUNK, h, dh)
    scores = jnp.einsum('bcqhd,bckhd->bchqk', qc, kb).astype(jnp.float32)
    qi = jnp.arange(CHUNK)[:, None]
    kj = jnp.arange(BAND * CHUNK)[None, :]
    dist = qi + N_LEFT_CHUNKS * CHUNK - kj
    rel_idx = jnp.clip(dist, -(CHUNK - 1), REL_MAX) + (CHUNK - 1)
    bias = rel_bias[:, rel_idx].astype(jnp.float32)
    key_chunk = jnp.arange(nc)[:, None] + jnp.repeat(jnp.arange(BAND), CHUNK)[None, :] - N_LEFT_CHUNKS
    valid = (key_chunk >= 0)[None, :, None, None, :]
    scores = jnp.where(valid, scores + bias[None, None], NEG_INF)
    probs = jax.nn.softmax(scores, axis=-1).astype(v.dtype)
    out = jnp.einsum('bchqk,bckhd->bcqhd', probs, vb)
    return out.reshape(b, s, h * dh)


def multiscale_pool(u, w_pool, pool_scale):
    b, s, c = u.shape
    uf = u.astype(jnp.float32)
    cs = jnp.pad(jnp.cumsum(uf, axis=1), ((0, 0), (1, 0), (0, 0)))
    t = jnp.arange(s)
    groups = []
    for gi, w in enumerate(POOL_WINDOWS):
        lo, hi = gi * B_GROUP_DIM, (gi + 1) * B_GROUP_DIM
        start = jnp.maximum(t + 1 - w, 0)
        count = (t + 1 - start).astype(jnp.float32)
        mean = (cs[:, 1:, lo:hi] - cs[:, start, lo:hi]) / count[None, :, None]
        groups.append(mean - uf[:, :, lo:hi])
    d = jnp.stack(groups, axis=2).astype(u.dtype)
    y = jnp.einsum('bsgi,gio->bsgo', d, w_pool).reshape(b, s, c)
    return y * pool_scale


def mixer_sublayer(x, g_pre, w_in, rel_bias, w_pool, pool_scale, w_out, g_post):
    b, s, _ = x.shape
    h = rmsnorm(x, g_pre)
    proj = h @ w_in
    q, k, v, gate_a, u_b, gate_b = jnp.split(
        proj, [A_WIDTH, 2 * A_WIDTH, 3 * A_WIDTH, 4 * A_WIDTH, 4 * A_WIDTH + B_WIDTH], axis=-1)
    shp = (b, s, A_HEADS, A_HEAD_DIM)
    att = chunked_rel_attention(q.reshape(shp), k.reshape(shp), v.reshape(shp), rel_bias)
    y_a = att * jax.nn.silu(gate_a)
    y_b = multiscale_pool(u_b, w_pool, pool_scale) * jax.nn.silu(gate_b)
    y = jnp.concatenate([y_a, y_b], axis=-1) @ w_out
    return x + rmsnorm(y, g_post)


def memory_xattn_sublayer(x, m, g_pre, w_xq, w_xk, w_xv, w_xo, g_post):
    b, s, _ = x.shape
    h = rmsnorm(x, g_pre)
    q = (h @ w_xq).reshape(b, s, XA_HEADS, XA_HEAD_DIM) * (XA_HEAD_DIM ** -0.5)
    k = (m @ w_xk).reshape(b, m.shape[1], XA_HEADS, XA_HEAD_DIM)
    v = (m @ w_xv).reshape(b, m.shape[1], XA_HEADS, XA_HEAD_DIM)
    scores = jnp.einsum('bshd,bmhd->bhsm', q, k).astype(jnp.float32)
    probs = jax.nn.softmax(scores, axis=-1).astype(v.dtype)
    out = jnp.einsum('bhsm,bmhd->bshd', probs, v).reshape(b, s, XA_WIDTH)
    return x + rmsnorm(out @ w_xo, g_post)


def setup_inputs(seed: int = 0) -> dict:
    key = jax.random.key(seed)
    ks = jax.random.split(key, 18)
    f32 = jnp.float32

    def nrm(k, shape, scale):
        return jax.random.normal(k, shape, f32) * scale

    def gain(k, shape):
        return 1.0 + 0.05 * jax.random.normal(k, shape, f32)

    return {
        "x": nrm(ks[0], (BATCH, SEQ, D_MODEL), 1.0),
        "mem": nrm(ks[1], (BATCH, N_MEM, D_MODEL), 1.0),
        "g_mix_pre": gain(ks[2], (DEPTH, D_MODEL)),
        "w_in": nrm(ks[3], (DEPTH, D_MODEL, IN_COLS), D_MODEL ** -0.5),
        "rel_bias": nrm(ks[4], (DEPTH, A_HEADS, REL_SIZE), 0.5),
        "w_pool": nrm(ks[5], (DEPTH, B_GROUPS, B_GROUP_DIM, B_GROUP_DIM), B_GROUP_DIM ** -0.5),
        "pool_scale": gain(ks[6], (DEPTH, B_WIDTH)),
        "w_out": nrm(ks[7], (DEPTH, MIX_WIDTH, D_MODEL), MIX_WIDTH ** -0.5),
        "g_mix_post": gain(ks[8], (DEPTH, D_MODEL)),
        "g_xa_pre": gain(ks[9], (DEPTH, D_MODEL)),
        "g_mem": gain(ks[10], (DEPTH, D_MODEL)),
        "w_xq": nrm(ks[11], (DEPTH, D_MODEL, XA_WIDTH), D_MODEL ** -0.5),
        "w_xk": nrm(ks[12], (DEPTH, D_MODEL, XA_WIDTH), D_MODEL ** -0.5),
        "w_xv": nrm(ks[13], (DEPTH, D_MODEL, XA_WIDTH), D_MODEL ** -0.5),
        "w_xo": nrm(ks[14], (DEPTH, XA_WIDTH, D_MODEL), XA_WIDTH ** -0.5),
        "g_xa_post": gain(ks[15], (DEPTH, D_MODEL)),
    }


def reference(x, mem, g_mix_pre, w_in, rel_bias, w_pool, pool_scale, w_out, g_mix_post,
              g_xa_pre, g_mem, w_xq, w_xk, w_xv, w_xo, g_xa_post):
    for layer in range(DEPTH):
        x = mixer_sublayer(x, g_mix_pre[layer], w_in[layer], rel_bias[layer], w_pool[layer],
                           pool_scale[layer], w_out[layer], g_mix_post[layer])
        m = rmsnorm(mem, g_mem[layer])
        x = memory_xattn_sublayer(x, m, g_xa_pre[layer], w_xq[layer], w_xk[layer], w_xv[layer],
                                  w_xo[layer], g_xa_post[layer])
    return x
```

```cpp
#include <hip/hip_runtime.h>
#include <cstdio>
#include <cstdint>
namespace pg8 {
#define PG8_LAS __attribute__((address_space(3)))
typedef unsigned short bf16_t;
typedef short bf16x8 __attribute__((ext_vector_type(8)));
typedef float f32x4 __attribute__((ext_vector_type(4)));
typedef unsigned u32x4 __attribute__((ext_vector_type(4)));
constexpr int BM = 256, BK = 64, HALF = 128, HTB = HALF * BK * 2  , STAGE_BYTES = 8 * HTB, NXCD = 8, WGM = 8;

__host__ __device__ __forceinline__ int lds_byte(int r, int c) { const int st = (r >> 4) * 2 + (c >> 5), rr = r & 15, cc = c & 31, ob = rr * 64 + cc * 2; return st * 1024 + (ob ^ (((ob >> 9) & 1) << 5)); }
__host__ __device__ __forceinline__ void stage_rc(int b, int& R, int& C) { const int st = b / 1024, sb = b % 1024, swz = sb ^ (((sb >> 9) & 1) << 5); R = (st >> 1) * 16 + swz / 64; C = (st & 1) * 32 + (swz % 64) / 2; }
__host__ __device__ __forceinline__ int perm32(int rho) { const int n = rho >> 4, i = rho & 15; return 8 * (i >> 2) + 4 * n + (i & 3); }

struct Unit { int pm, pn; };
struct Gemm { const bf16_t* A; const bf16_t* Bt; int M, N, K; };

struct StaticOrder {
    int nM, nN, nwg, G, c;
    __host__ __device__ void init(int M, int N, int G_, int c_) { nM = M / BM; nN = N / BM; nwg = nM * nN; G = G_; c = c_; }
    __host__ __device__ bool next(int i, Unit& u) const {
        const long L = (long)i * G + c; if (L >= nwg) return false;
        int wgid = (int)L; { const int q = nwg / NXCD, r = nwg % NXCD, xcd = wgid % NXCD, off = wgid / NXCD; wgid = (xcd < r ? xcd * (q + 1) : r * (q + 1) + (xcd - r) * q) + off; }
        const int nig = WGM * nN, gid = wgid / nig, fm = gid * WGM, gsz = (nM - fm) < WGM ? (nM - fm) : WGM;
        u.pm = fm + ((wgid % nig) % gsz); u.pn = (wgid % nig) / gsz; return true;
    }
    __device__ __forceinline__ void a_ready(const Unit&) const {}
    __device__ __forceinline__ void done(const Unit&) const {}
};

__device__ __forceinline__ unsigned cvt_pk_bf16(float lo, float hi) { unsigned r; asm volatile("v_cvt_pk_bf16_f32 %0, %1, %2" : "=v"(r) : "v"(lo), "v"(hi)); return r; }
typedef float f32x2 __attribute__((ext_vector_type(2)));
__device__ __forceinline__ f32x2 gelu_pk(f32x2 v) {
    const f32x2 av = __builtin_elementwise_abs(v), d = av * 0.2316418882f + 1.0f;
    f32x2 t; t.x = __builtin_amdgcn_rcpf(d.x); t.y = __builtin_amdgcn_rcpf(d.y);
    f32x2 q = t * 0.5307027145f + (-0.7265760135f); q = q * t + 0.7107068705f; q = q * t + (-0.142248368f); q = q * t + 0.127414796f; q = q * t;
    const f32x2 s = (v * v) * (-0.72134752044f);
    f32x2 e; e.x = __builtin_amdgcn_exp2f(s.x); e.y = __builtin_amdgcn_exp2f(s.y);
    const f32x2 m = v * (q * e), r = v - m;
    f32x2 o; o.x = v.x < 0.f ? m.x : r.x; o.y = v.y < 0.f ? m.y : r.y; return o;
}

template <int ACT  > struct EpiBf16 {
    static constexpr bool PERM = true, AFTER_DRAIN = false; static_assert(ACT == 0 || ACT == 1, "EpiBf16: ACT is 0 (none) or 1 (gelu_pk)");
    bf16_t* O; int ldc; const float* bias; int split_cols; size_t split_stride; float scale0;
    __device__ __forceinline__ void operator()(const f32x4 (&acc)[2][2][4][2], const Unit& u, int wr, int wc, int fr, int fq) const {
        const int row0 = u.pm * BM + wr * 64 + fr; int colt = u.pn * BM; bf16_t* base = O;
        float sc = 1.f; if (split_cols) { const int t = colt / split_cols; base += (size_t)t * split_stride; colt -= t * split_cols; if (t == 0) sc = scale0; }
        const int col0 = colt + wc * 32 + 8 * fq, bcol0 = u.pn * BM + wc * 32 + 8 * fq;
        f32x4 bv[2][2];
#pragma unroll
        for (int bj = 0; bj < 2; ++bj)
#pragma unroll
            for (int n = 0; n < 2; ++n) bv[bj][n] = bias ? *(const f32x4*)(bias + bcol0 + bj * HALF + 4 * n) : (f32x4){0.f, 0.f, 0.f, 0.f};
#pragma unroll
        for (int ai = 0; ai < 2; ++ai)
#pragma unroll
            for (int m = 0; m < 4; ++m) { bf16_t* rowp = base + (size_t)(row0 + ai * HALF + m * 16) * ldc + col0;
#pragma unroll
                for (int bj = 0; bj < 2; ++bj) { f32x4 v0 = acc[ai][bj][m][0] + bv[bj][0], v1 = acc[ai][bj][m][1] + bv[bj][1];
                    if (ACT == 1) { f32x2 a = gelu_pk((f32x2){v0[0], v0[1]}), b = gelu_pk((f32x2){v0[2], v0[3]}), c = gelu_pk((f32x2){v1[0], v1[1]}), d = gelu_pk((f32x2){v1[2], v1[3]});
                        v0 = (f32x4){a.x, a.y, b.x, b.y}; v1 = (f32x4){c.x, c.y, d.x, d.y}; }
                    v0 = v0 * sc; v1 = v1 * sc; u32x4 w; w.x = cvt_pk_bf16(v0[0], v0[1]); w.y = cvt_pk_bf16(v0[2], v0[3]); w.z = cvt_pk_bf16(v1[0], v1[1]); w.w = cvt_pk_bf16(v1[2], v1[3]);
                    *(u32x4*)(rowp + bj * HALF) = w; } }
    }
};

struct PanelStats {
    unsigned* xbuf;
    unsigned* cnt;
    unsigned* tmo;
    int ntn; float eps;
    unsigned code;
    __device__ __forceinline__ bool run(const f32x4 (&v)[2][2][4][2], const Unit& u, int wr, int wc, int fr, int fq, PG8_LAS unsigned char* lds, int wid, int lane) const {
        typedef float f32x2v __attribute__((ext_vector_type(2)));
        PG8_LAS f32x2v* P = (PG8_LAS f32x2v*)lds;
        PG8_LAS f32x2v* S = (PG8_LAS f32x2v*)(lds + 8192);
        PG8_LAS unsigned* flag = (PG8_LAS unsigned*)(lds + 8192 + 2048);
#pragma unroll
        for (int ai = 0; ai < 2; ++ai)
#pragma unroll
            for (int m = 0; m < 4; ++m) {
                float s = 0.f;
#pragma unroll
                for (int bj = 0; bj < 2; ++bj)
#pragma unroll
                    for (int n = 0; n < 2; ++n) { const f32x4 x = v[ai][bj][m][n]; s += (x[0] + x[1]) + (x[2] + x[3]); }
                s += __shfl_xor(s, 16); s += __shfl_xor(s, 32);
                const float mw = s * (1.0f / 64.0f); float q = 0.f;
#pragma unroll
                for (int bj = 0; bj < 2; ++bj)
#pragma unroll
                    for (int n = 0; n < 2; ++n) { const f32x4 d = v[ai][bj][m][n] - mw; q += (d[0] * d[0] + d[1] * d[1]) + (d[2] * d[2] + d[3] * d[3]); }
                q += __shfl_xor(q, 16); q += __shfl_xor(q, 32);
                if (fq == 0) P[(ai * HALF + wr * 64 + m * 16 + fr) * 4 + wc] = (f32x2v){mw, q};
            }
        asm volatile("s_waitcnt lgkmcnt(0)" ::: "memory"); __builtin_amdgcn_s_barrier(); asm volatile("" ::: "memory");
#if defined(BROKEN_EXCHANGE_NO_WAIT)
#warning BROKEN CONTROL BUILD: the row-statistics exchange does not wait; results are wrong by design
        if (blockIdx.x >= 64) { const long long t0_ = clock64(); while (clock64() - t0_ < 60000) __builtin_amdgcn_s_sleep(8); }
#endif
        const int row = wid * 32 + (lane & 31);
        if (lane < 32) {
            const f32x2v a = P[row * 4 + 0], b = P[row * 4 + 1], c = P[row * 4 + 2], d = P[row * 4 + 3];
            const float mt = (a.x + b.x + c.x + d.x) * 0.25f;
            const float da = a.x - mt, db = b.x - mt, dc = c.x - mt, dd = d.x - mt;
            const float m2 = (a.y + b.y) + (c.y + d.y) + 64.0f * ((da * da + db * db) + (dc * dc + dd * dd));
            unsigned long long* slot = (unsigned long long*)xbuf + ((size_t)(u.pm * BM + row) * 4 + u.pn);
            __hip_atomic_store(slot, ((unsigned long long)__float_as_uint(m2) << 32) | __float_as_uint(mt), __ATOMIC_RELAXED, __HIP_MEMORY_SCOPE_AGENT);
        }
        asm volatile("s_waitcnt vmcnt(0)" ::: "memory");
        if (lane == 0) __hip_atomic_fetch_add(cnt + 64 * u.pm, 1u, __ATOMIC_RELAXED, __HIP_MEMORY_SCOPE_AGENT);
        if (wid == 0) {
            bool dead = false; const unsigned long long t0 = __builtin_amdgcn_s_memrealtime(); const unsigned want = 8u * (unsigned)ntn;
            for (;;) {
#if defined(BROKEN_EXCHANGE_NO_WAIT)
                break;
#endif
                if ((unsigned)__builtin_amdgcn_readfirstlane(__hip_atomic_load(cnt + 64 * u.pm, __ATOMIC_RELAXED, __HIP_MEMORY_SCOPE_AGENT)) >= want) break;
                if (__builtin_amdgcn_s_memrealtime() - t0 > 2000000ull) {
                    if (lane == 0) { unsigned expect = 0u; __hip_atomic_compare_exchange_strong(tmo + 1, &expect, code | (unsigned)(u.pm & 0xff), __ATOMIC_RELAXED, __ATOMIC_RELAXED, __HIP_MEMORY_SCOPE_AGENT);
                                     __hip_atomic_store(tmo, 1u, __ATOMIC_RELAXED, __HIP_MEMORY_SCOPE_AGENT); }
                    dead = true; break; }
                __builtin_amdgcn_s_sleep(2);
            }
            __builtin_amdgcn_fence(__ATOMIC_ACQUIRE, "agent");
            if (lane == 0) flag[0] = dead ? 1u : 0u;
        }
        asm volatile("s_waitcnt vmcnt(0) lgkmcnt(0)" ::: "memory"); __builtin_amdgcn_s_barrier(); asm volatile("" ::: "memory");
        const bool bad = flag[0] != 0u;
        if (lane < 32) {
            const unsigned long long* slot = (const unsigned long long*)xbuf + (size_t)(u.pm * BM + row) * 4; float mt[4], m2[4]; float ms = 0.f;
#pragma unroll
            for (int t = 0; t < 4; ++t) { if (t < ntn) { const unsigned long long w = __hip_atomic_load(slot + t, __ATOMIC_RELAXED, __HIP_MEMORY_SCOPE_AGENT); mt[t] = __uint_as_float((unsigned)w); m2[t] = __uint_as_float((unsigned)(w >> 32)); } else { mt[t] = 0.f; m2[t] = 0.f; } ms += mt[t]; }
            const float mean = ms / (float)ntn; float q = 0.f;
#pragma unroll
            for (int t = 0; t < 4; ++t) if (t < ntn) { const float dm = mt[t] - mean; q += m2[t] + 256.0f * dm * dm; }
            S[row] = (f32x2v){mean, 1.0f / sqrtf(q / (256.0f * (float)ntn) + eps)};
        }
        asm volatile("s_waitcnt lgkmcnt(0)" ::: "memory"); __builtin_amdgcn_s_barrier(); asm volatile("" ::: "memory");
        return bad;
    }
};
struct EpiLnRes {
    static constexpr bool PERM = false, AFTER_DRAIN = true;
    const float* base; float* out; int ldc; const float* bias; PanelStats st; unsigned poison;
    __device__ __forceinline__ void fused(f32x4 (&acc)[2][2][4][2], const Unit& u, int wr, int wc, int fr, int fq, PG8_LAS unsigned char* lds, int wid, int lane) const {
        typedef float f32x2v __attribute__((ext_vector_type(2)));
        const PG8_LAS f32x2v* S = (const PG8_LAS f32x2v*)(lds + 8192);
        const int col0 = u.pn * BM + wc * 32 + 4 * fq;
#pragma unroll
        for (int bj = 0; bj < 2; ++bj)
#pragma unroll
            for (int n = 0; n < 2; ++n) { const f32x4 bv = bias ? *(const f32x4*)(bias + col0 + bj * HALF + n * 16) : (f32x4){0.f, 0.f, 0.f, 0.f};
#pragma unroll
                for (int ai = 0; ai < 2; ++ai)
#pragma unroll
                    for (int m = 0; m < 4; ++m) acc[ai][bj][m][n] += bv; }
        f32x4 pre[4][2][2];
#pragma unroll
        for (int m = 0; m < 4; ++m) { const size_t off = (size_t)(u.pm * BM + wr * 64 + m * 16 + fr) * ldc + col0;
#pragma unroll
            for (int bj = 0; bj < 2; ++bj)
#pragma unroll
                for (int n = 0; n < 2; ++n) pre[m][bj][n] = *(const f32x4*)(base + off + bj * HALF + n * 16); }
        const bool bad = st.run(acc, u, wr, wc, fr, fq, lds, wid, lane) || poison != 0u;
        const float qnan = __builtin_nanf("");
#pragma unroll
        for (int ai = 0; ai < 2; ++ai)
#pragma unroll
            for (int m = 0; m < 4; ++m) { const int r = ai * HALF + wr * 64 + m * 16 + fr; const f32x2v sr = S[r]; const size_t off = (size_t)(u.pm * BM + r) * ldc + col0;
#pragma unroll
                for (int bj = 0; bj < 2; ++bj)
#pragma unroll
                    for (int n = 0; n < 2; ++n) { const f32x4 bs = ai == 0 ? pre[m][bj][n] : *(const f32x4*)(base + off + bj * HALF + n * 16); f32x4 o = bs + (acc[ai][bj][m][n] - sr.x) * sr.y;
                        if (bad) o = (f32x4){qnan, qnan, qnan, qnan}; *(f32x4*)(out + off + bj * HALF + n * 16) = o; }
                if (m & 1) asm volatile("" ::: "memory"); }
    }
};
struct EpiLnResLn {
    static constexpr bool PERM = false, AFTER_DRAIN = true;
    const float* base; float* out; bf16_t* xn; int ldc; const float* bias; PanelStats st1, st2; unsigned poison;
    __device__ __forceinline__ void fused(f32x4 (&acc)[2][2][4][2], const Unit& u, int wr, int wc, int fr, int fq, PG8_LAS unsigned char* lds, int wid, int lane) const {
        typedef float f32x2v __attribute__((ext_vector_type(2))); typedef unsigned u32x2v __attribute__((ext_vector_type(2)));
        const PG8_LAS f32x2v* S = (const PG8_LAS f32x2v*)(lds + 8192);
        const int col0 = u.pn * BM + wc * 32 + 4 * fq;
#pragma unroll
        for (int bj = 0; bj < 2; ++bj)
#pragma unroll
            for (int n = 0; n < 2; ++n) { const f32x4 bv = bias ? *(const f32x4*)(bias + col0 + bj * HALF + n * 16) : (f32x4){0.f, 0.f, 0.f, 0.f};
#pragma unroll
                for (int ai = 0; ai < 2; ++ai)
#pragma unroll
                    for (int m = 0; m < 4; ++m) acc[ai][bj][m][n] += bv; }
        bool bad = st1.run(acc, u, wr, wc, fr, fq, lds, wid, lane) || poison != 0u;
        const float qnan = __builtin_nanf("");
#pragma unroll
        for (int ai = 0; ai < 2; ++ai)
#pragma unroll
            for (int m = 0; m < 4; ++m) { const int r = ai * HALF + wr * 64 + m * 16 + fr; const f32x2v sr = S[r]; const size_t off = (size_t)(u.pm * BM + r) * ldc + col0;
#pragma unroll
                for (int bj = 0; bj < 2; ++bj)
#pragma unroll
                    for (int n = 0; n < 2; ++n) { const f32x4 bs = *(const f32x4*)(base + off + bj * HALF + n * 16); acc[ai][bj][m][n] = bs + (acc[ai][bj][m][n] - sr.x) * sr.y; }
                asm volatile("" : "+v"(acc[ai][0][m][0]), "+v"(acc[ai][0][m][1]), "+v"(acc[ai][1][m][0]), "+v"(acc[ai][1][m][1]));
                if (m & 1) asm volatile("" ::: "memory"); }
        const bool bad1 = bad;
        bad = st2.run(acc, u, wr, wc, fr, fq, lds, wid, lane) || bad;
#pragma unroll
        for (int ai = 0; ai < 2; ++ai)
#pragma unroll
            for (int m = 0; m < 4; ++m) { const int r = ai * HALF + wr * 64 + m * 16 + fr; const f32x2v sr = S[r]; const size_t off = (size_t)(u.pm * BM + r) * ldc + col0;
#pragma unroll
                for (int bj = 0; bj < 2; ++bj)
#pragma unroll
                    for (int n = 0; n < 2; ++n) { const f32x4 x1 = acc[ai][bj][m][n]; *(f32x4*)(out + off + bj * HALF + n * 16) = bad1 ? (f32x4){qnan, qnan, qnan, qnan} : x1;
                        const f32x4 o = (x1 - sr.x) * sr.y; u32x2v w; w.x = cvt_pk_bf16(o[0], o[1]); w.y = cvt_pk_bf16(o[2], o[3]);
                        if (bad) { w.x = 0x7fc07fc0u; w.y = 0x7fc07fc0u; } *(u32x2v*)(xn + off + bj * HALF + n * 16) = w; }
                asm volatile("" ::: "memory"); }
    }
};

template <class Epi, class Sched, bool ALIGN_EPI = false, bool SP2 = false>
__device__ __forceinline__ void gemm_phase(PG8_LAS unsigned char* lds, const Gemm g, const Sched& S, const Epi& E) {
    const int tid = threadIdx.x, wid = __builtin_amdgcn_readfirstlane(tid >> 6), lane = tid & 63, wr = wid >> 2, wc = wid & 3, fr = lane & 15, fq = lane >> 4;
    const int K = g.K, nt = K / BK;
    unsigned voffA[2], voffB[2];
#pragma unroll
    for (int i = 0; i < 2; ++i) { int R, C; stage_rc(tid * 16 + i * 8192, R, C); const int Rb = Epi::PERM ? ((R & ~31) + perm32(R & 31)) : R;
        voffA[i] = (unsigned)(R * K + C) * 2u; voffB[i] = (unsigned)(Rb * K + C) * 2u; }
    const size_t kstep = (size_t)(BK * 2);
    const size_t hstep = (size_t)HALF * K * 2;
    const size_t tstep = 2 * hstep;
    const unsigned ldsw = (unsigned)wid * 1024u;
    const int aoff = lds_byte(wr * 64 + fr, fq * 8), boff = lds_byte(wc * 32 + fr, fq * 8);
#define PG8_SA(b, h) (((b) * 2 + (h)) * HTB)
#define PG8_SB(b, h) ((4 + (b) * 2 + (h)) * HTB)
#define PG8_STAGE(bufoff, gbase, voff) do { _Pragma("unroll") for (int _i = 0; _i < 2; ++_i) \
        __builtin_amdgcn_global_load_lds((const unsigned*)((const char*)(gbase) + (voff)[_i]), (PG8_LAS unsigned*)(lds + (bufoff) + ldsw + _i * 8192), 16, 0, 0); } while (0)
#define PG8_LDA(dst, b, h) do { _Pragma("unroll") for (int m = 0; m < 4; ++m) _Pragma("unroll") for (int k = 0; k < 2; ++k) dst[m][k] = *(const PG8_LAS bf16x8*)(lds + PG8_SA(b, h) + aoff + m * 2048 + k * 1024); } while (0)
#define PG8_LDB(dst, b, h) do { _Pragma("unroll") for (int n = 0; n < 2; ++n) _Pragma("unroll") for (int k = 0; k < 2; ++k) dst[n][k] = *(const PG8_LAS bf16x8*)(lds + PG8_SB(b, h) + boff + n * 2048 + k * 1024); } while (0)
#define PG8_MMA(ai, bj, At, Bt) do { __builtin_amdgcn_s_setprio(1); _Pragma("unroll") for (int m = 0; m < 4; ++m) _Pragma("unroll") for (int n = 0; n < 2; ++n) _Pragma("unroll") for (int k = 0; k < 2; ++k) \
        acc[ai][bj][m][n] = __builtin_amdgcn_mfma_f32_16x16x32_bf16(Bt[n][k], At[m][k], acc[ai][bj][m][n], 0, 0, 0); __builtin_amdgcn_s_setprio(0); } while (0)
#define PG8_WAIT_V(n) asm volatile("s_waitcnt vmcnt(" #n ")" ::: "memory")
#define PG8_WAIT_L(n) asm volatile("s_waitcnt lgkmcnt(" #n ")" ::: "memory")
#define PG8_BAR __builtin_amdgcn_s_barrier()
#define PG8_SCHED __builtin_amdgcn_sched_barrier(0)
    Unit cur, nxt; int ui = 0;
    if (!S.next(0, cur)) return;
    f32x4 acc[2][2][4][2];
#pragma unroll
    for (int a = 0; a < 2; ++a)
#pragma unroll
        for (int b = 0; b < 2; ++b)
#pragma unroll
            for (int m = 0; m < 4; ++m)
#pragma unroll
                for (int n = 0; n < 2; ++n) acc[a][b][m][n] = (f32x4){0.f, 0.f, 0.f, 0.f};
    bf16x8 At[4][2], B0[2][2], B1[2][2];
    const char* cA = (const char*)g.A + (size_t)cur.pm * tstep; const char* cB = (const char*)g.Bt + (size_t)cur.pn * tstep;
    S.a_ready(cur);
    if constexpr (SP2) {
        PG8_STAGE(PG8_SB(0, 0), cB, voffB); PG8_STAGE(PG8_SB(0, 1), cB + hstep, voffB); PG8_STAGE(PG8_SA(0, 0), cA, voffA); PG8_STAGE(PG8_SA(0, 1), cA + hstep, voffA);
        if (wr == 1) PG8_BAR;
        PG8_WAIT_V(2); PG8_BAR;
        PG8_STAGE(PG8_SB(1, 0), cB + kstep, voffB); PG8_STAGE(PG8_SA(1, 0), cA + kstep, voffA); PG8_STAGE(PG8_SB(1, 1), cB + hstep + kstep, voffB);
        PG8_WAIT_V(6); PG8_BAR;
    } else {
        PG8_STAGE(PG8_SB(0, 0), cB, voffB); PG8_STAGE(PG8_SA(0, 0), cA, voffA); PG8_STAGE(PG8_SB(0, 1), cB + hstep, voffB); PG8_STAGE(PG8_SA(0, 1), cA + hstep, voffA);
        if (wr == 1) PG8_BAR;
        PG8_WAIT_V(4); PG8_BAR;
        PG8_STAGE(PG8_SB(1, 0), cB + kstep, voffB); PG8_STAGE(PG8_SA(1, 0), cA + kstep, voffA); PG8_STAGE(PG8_SB(1, 1), cB + hstep + kstep, voffB);
        PG8_WAIT_V(6); PG8_BAR;
    }
    for (;;) {
        const bool has_next = S.next(ui + 1, nxt);
        const char* nA = has_next ? (const char*)g.A + (size_t)nxt.pm * tstep : cA; const char* nB = has_next ? (const char*)g.Bt + (size_t)nxt.pn * tstep : cB;
        for (int t = 0; t < nt; t += 2) {
            const bool last = (t == nt - 2);
            const char* a1 = cA + (size_t)(t + 1) * kstep;
            const char* a2 = last ? nA : cA + (size_t)(t + 2) * kstep; const char* b2 = last ? nB : cB + (size_t)(t + 2) * kstep;
            const char* a3 = a2 + kstep; const char* b3 = b2 + kstep;
            if (last && has_next) S.a_ready(nxt);
            if constexpr (SP2) {
            PG8_LDB(B0, 0, 0); PG8_LDB(B1, 0, 1); PG8_SCHED; PG8_LDA(At, 0, 0); PG8_STAGE(PG8_SA(1, 1), a1 + hstep, voffA);
            PG8_WAIT_V(8); PG8_WAIT_L(0); PG8_BAR; PG8_MMA(0, 0, At, B0); PG8_MMA(0, 1, At, B1); PG8_BAR; PG8_SCHED;
            PG8_LDA(At, 0, 1); PG8_STAGE(PG8_SB(0, 0), b2, voffB); PG8_STAGE(PG8_SB(0, 1), b2 + hstep, voffB); PG8_STAGE(PG8_SA(0, 0), a2, voffA);
            PG8_WAIT_V(8); PG8_WAIT_L(0); PG8_BAR; PG8_MMA(1, 0, At, B0); PG8_MMA(1, 1, At, B1); PG8_BAR; PG8_SCHED;
            PG8_LDB(B0, 1, 0); PG8_LDB(B1, 1, 1); PG8_SCHED; PG8_LDA(At, 1, 0); PG8_STAGE(PG8_SA(0, 1), a2 + hstep, voffA);
            PG8_WAIT_V(8); PG8_WAIT_L(0); PG8_BAR; PG8_MMA(0, 0, At, B0); PG8_MMA(0, 1, At, B1); PG8_BAR; PG8_SCHED;
            PG8_LDA(At, 1, 1); PG8_STAGE(PG8_SB(1, 0), b3, voffB); PG8_STAGE(PG8_SB(1, 1), b3 + hstep, voffB); PG8_STAGE(PG8_SA(1, 0), a3, voffA);
            PG8_WAIT_V(8); PG8_WAIT_L(0); PG8_BAR; PG8_MMA(1, 0, At, B0); PG8_MMA(1, 1, At, B1); PG8_BAR; PG8_SCHED;
            } else {
            PG8_LDB(B0, 0, 0); PG8_SCHED; PG8_LDA(At, 0, 0); PG8_STAGE(PG8_SA(1, 1), a1 + hstep, voffA);
            PG8_WAIT_L(8); PG8_BAR; PG8_WAIT_L(0); PG8_MMA(0, 0, At, B0); PG8_BAR; PG8_SCHED;
            PG8_LDB(B1, 0, 1); PG8_STAGE(PG8_SB(0, 0), b2, voffB);
            PG8_BAR; PG8_WAIT_L(0); PG8_MMA(0, 1, At, B1); PG8_BAR;
            PG8_LDA(At, 0, 1); PG8_STAGE(PG8_SA(0, 0), a2, voffA);
            PG8_BAR; PG8_WAIT_L(0); PG8_MMA(1, 0, At, B0); PG8_BAR; PG8_SCHED;
            PG8_STAGE(PG8_SB(0, 1), b2 + hstep, voffB);
            PG8_WAIT_V(6); PG8_BAR; PG8_MMA(1, 1, At, B1); PG8_BAR;
            PG8_LDB(B0, 1, 0); PG8_SCHED; PG8_LDA(At, 1, 0); PG8_STAGE(PG8_SA(0, 1), a2 + hstep, voffA);
            PG8_WAIT_L(8); PG8_BAR; PG8_WAIT_L(0); PG8_MMA(0, 0, At, B0); PG8_BAR; PG8_SCHED;
            PG8_LDB(B1, 1, 1); PG8_STAGE(PG8_SB(1, 0), b3, voffB);
            PG8_BAR; PG8_WAIT_L(0); PG8_MMA(0, 1, At, B1); PG8_BAR;
            PG8_LDA(At, 1, 1); PG8_STAGE(PG8_SA(1, 0), a3, voffA);
            PG8_BAR; PG8_WAIT_L(0); PG8_MMA(1, 0, At, B0); PG8_BAR; PG8_SCHED;
            PG8_STAGE(PG8_SB(1, 1), b3 + hstep, voffB);
            PG8_WAIT_V(6); PG8_BAR; PG8_MMA(1, 1, At, B1); PG8_BAR;
            }
        }
        if constexpr (ALIGN_EPI) { if (wr == 0) PG8_BAR; }
        if constexpr (!Epi::AFTER_DRAIN) { E(acc, cur, wr, wc, fr, fq); S.done(cur); }
        if (!has_next) break;
#pragma unroll
        for (int a = 0; a < 2; ++a)
#pragma unroll
            for (int b = 0; b < 2; ++b)
#pragma unroll
                for (int m = 0; m < 4; ++m)
#pragma unroll
                    for (int n = 0; n < 2; ++n) acc[a][b][m][n] = (f32x4){0.f, 0.f, 0.f, 0.f};
        cur = nxt; cA = nA; cB = nB; ++ui;
        if constexpr (ALIGN_EPI) { if (wr == 1) PG8_BAR; }
    }
    PG8_WAIT_V(0);
    if constexpr (!ALIGN_EPI) { if (wr == 0) PG8_BAR; }
    PG8_BAR;
    if constexpr (Epi::AFTER_DRAIN) { E.fused(acc, cur, wr, wc, fr, fq, lds, wid, lane); S.done(cur); }
#undef PG8_SA
#undef PG8_SB
#undef PG8_STAGE
#undef PG8_LDA
#undef PG8_LDB
#undef PG8_MMA
#undef PG8_WAIT_V
#undef PG8_WAIT_L
#undef PG8_BAR
#undef PG8_SCHED
}
}
namespace pg8 {
struct EpiF32 {
    static constexpr bool PERM = false, AFTER_DRAIN = false;
    float* C; int ldc;
    __device__ __forceinline__ void operator()(const f32x4 (&acc)[2][2][4][2], const Unit& u, int wr, int wc, int fr, int fq) const {
        const int row0 = u.pm * BM + wr * 64 + fr, col0 = u.pn * BM + wc * 32 + 4 * fq;
#pragma unroll
        for (int ai = 0; ai < 2; ++ai)
#pragma unroll
            for (int m = 0; m < 4; ++m) { float* rowp = C + (size_t)(row0 + ai * HALF + m * 16) * ldc + col0;
#pragma unroll
                for (int bj = 0; bj < 2; ++bj)
#pragma unroll
                    for (int n = 0; n < 2; ++n) *(f32x4*)(rowp + bj * HALF + n * 16) = acc[ai][bj][m][n]; }
    }
};
}

typedef unsigned short bf16_t;
constexpr int D_MODEL = 4096, BATCH = 4, SEQ = 2048, NTOK = BATCH * SEQ;
constexpr int CHUNK = 64, NCHUNK = SEQ / CHUNK, A_WIDTH = 2048, A_HD = 128, A_HEADS = 16, REL_SIZE = 192;
constexpr int B_WIDTH = 2048, B_GROUPS = 4, B_GD = 512, IN_COLS = 12288;
constexpr int XA_HEADS = 4, XA_HD = 256, XA_WIDTH = 1024, N_MEM = 256, NMTOK = BATCH * N_MEM;
constexpr float EPS = 1e-6f;
constexpr int COL_Q = 0, COL_K = 2048, COL_V = 4096, COL_GA = 6144, COL_U = 8192, COL_GB = 10240;

__device__ __forceinline__ float bf2f(bf16_t v) { return __uint_as_float(((unsigned)v) << 16); }
__device__ __forceinline__ bf16_t f2bf(float f) { unsigned u = __float_as_uint(f); return (bf16_t)((u + 0x7fffu + ((u >> 16) & 1u)) >> 16); }
__device__ __forceinline__ float silu_f(float x) { return x / (1.f + __expf(-x)); }
__device__ __forceinline__ float wave_sum_f(float v) {
#pragma unroll
    for (int o = 32; o > 0; o >>= 1) v += __shfl_xor(v, o);
    return v;
}
__device__ __forceinline__ float wave_max_f(float v) {
#pragma unroll
    for (int o = 32; o > 0; o >>= 1) v = fmaxf(v, __shfl_xor(v, o));
    return v;
}

__global__ void __launch_bounds__(256) k_transpose_bf16(const float* __restrict__ W, bf16_t* __restrict__ WT, int K, int N) {
    __shared__ float tile[32][33];
    const int n0 = blockIdx.x * 32, k0 = blockIdx.y * 32, tx = threadIdx.x & 31, ty = threadIdx.x >> 5;
    for (int i = ty; i < 32; i += 8) tile[i][tx] = W[(size_t)(k0 + i) * N + n0 + tx];
    __syncthreads();
    for (int i = ty; i < 32; i += 8) WT[(size_t)(n0 + i) * K + k0 + tx] = f2bf(tile[tx][i]);
}

__global__ void __launch_bounds__(256) k_rmsnorm_bf16(const float* __restrict__ x, const float* __restrict__ g, bf16_t* __restrict__ out) {
    __shared__ float red[4];
    const float* xr = x + (size_t)blockIdx.x * D_MODEL;
    float4 v[4]; float ss = 0.f;
#pragma unroll
    for (int j = 0; j < 4; ++j) { v[j] = *(const float4*)(xr + j * 1024 + threadIdx.x * 4); ss += v[j].x * v[j].x + v[j].y * v[j].y + v[j].z * v[j].z + v[j].w * v[j].w; }
    ss = wave_sum_f(ss);
    if ((threadIdx.x & 63) == 0) red[threadIdx.x >> 6] = ss;
    __syncthreads();
    const float rs = rsqrtf((red[0] + red[1] + red[2] + red[3]) * (1.f / D_MODEL) + EPS);
    bf16_t* orow = out + (size_t)blockIdx.x * D_MODEL;
#pragma unroll
    for (int j = 0; j < 4; ++j) { const int c = j * 1024 + threadIdx.x * 4; const float4 gg = *(const float4*)(g + c);
        orow[c + 0] = f2bf(v[j].x * rs * gg.x); orow[c + 1] = f2bf(v[j].y * rs * gg.y); orow[c + 2] = f2bf(v[j].z * rs * gg.z); orow[c + 3] = f2bf(v[j].w * rs * gg.w); }
}

__global__ void __launch_bounds__(256) k_attn_naive(const bf16_t* __restrict__ proj, const float* __restrict__ rel_bias, bf16_t* __restrict__ ycat) {
    __shared__ float qs[4][128];
    __shared__ float ps[4][576];
    const int blk = blockIdx.x, h = blk % A_HEADS, c = (blk / A_HEADS) % NCHUNK, b = blk / (A_HEADS * NCHUNK);
    const int wave = threadIdx.x >> 6, lane = threadIdx.x & 63;
    const float scale = 0.08838834764831845f;
    for (int qi = wave; qi < CHUNK; qi += 4) {
        const size_t row = (size_t)b * SEQ + c * CHUNK + qi;
        const bf16_t* qp = proj + row * IN_COLS + COL_Q + h * A_HD;
        qs[wave][lane * 2] = bf2f(qp[lane * 2]) * scale; qs[wave][lane * 2 + 1] = bf2f(qp[lane * 2 + 1]) * scale;
        __syncthreads();
        float mx = -3.0e38f;
#pragma unroll 1
        for (int i = 0; i < 9; ++i) {
            const int kc = c + i - 8;
            if (kc >= 0) {
                const bf16_t* kp = proj + ((size_t)b * SEQ + kc * CHUNK + lane) * IN_COLS + COL_K + h * A_HD;
                float dot = 0.f;
#pragma unroll 2
                for (int d = 0; d < A_HD; d += 8) { const uint4 raw = *(const uint4*)(kp + d);
                    dot += qs[wave][d + 0] * __uint_as_float(raw.x << 16) + qs[wave][d + 1] * __uint_as_float(raw.x & 0xffff0000u)
                         + qs[wave][d + 2] * __uint_as_float(raw.y << 16) + qs[wave][d + 3] * __uint_as_float(raw.y & 0xffff0000u)
                         + qs[wave][d + 4] * __uint_as_float(raw.z << 16) + qs[wave][d + 5] * __uint_as_float(raw.z & 0xffff0000u)
                         + qs[wave][d + 6] * __uint_as_float(raw.w << 16) + qs[wave][d + 7] * __uint_as_float(raw.w & 0xffff0000u); }
                int dist = qi + 512 - (i * 64 + lane); dist = dist < -63 ? -63 : (dist > 128 ? 128 : dist);
                const float sv = dot + rel_bias[h * REL_SIZE + dist + 63];
                ps[wave][i * 64 + lane] = sv;
                mx = fmaxf(mx, sv);
            }
        }
        mx = wave_max_f(mx);
        float l = 0.f;
#pragma unroll 1
        for (int i = 0; i < 9; ++i) { const int kc = c + i - 8; const float p = (kc >= 0) ? __expf(ps[wave][i * 64 + lane] - mx) : 0.f; ps[wave][i * 64 + lane] = p; l += p; }
        l = wave_sum_f(l);
        __syncthreads();
        float a0 = 0.f, a1 = 0.f;
        for (int i = 0; i < 9; ++i) { const int kc = c + i - 8; if (kc < 0) continue;
            const bf16_t* vp = proj + ((size_t)b * SEQ + kc * CHUNK) * IN_COLS + COL_V + h * A_HD + 2 * lane;
#pragma unroll 4
            for (int kk = 0; kk < 64; ++kk) { const float p = ps[wave][i * 64 + kk]; const unsigned raw = *(const unsigned*)(vp + (size_t)kk * IN_COLS);
                a0 += p * __uint_as_float(raw << 16); a1 += p * __uint_as_float(raw & 0xffff0000u); } }
        const float inv = 1.f / l;
        const unsigned graw = *(const unsigned*)(proj + row * IN_COLS + COL_GA + h * A_HD + 2 * lane);
        const float y0 = a0 * inv * silu_f(__uint_as_float(graw << 16)), y1 = a1 * inv * silu_f(__uint_as_float(graw & 0xffff0000u));
        *(unsigned*)(ycat + row * D_MODEL + h * A_HD + 2 * lane) = (unsigned)f2bf(y0) | ((unsigned)f2bf(y1) << 16);
        __syncthreads();
    }
}

__global__ void __launch_bounds__(256) k_pool_d(const bf16_t* __restrict__ proj, bf16_t* __restrict__ Dg) {
    const int row = blockIdx.x, t = row % SEQ, ch0 = threadIdx.x * 8, g = ch0 / B_GD, w = 2 << g;
    const int start = (t + 1 - w) > 0 ? (t + 1 - w) : 0, cnt = t + 1 - start;
    float acc[8];
#pragma unroll
    for (int e = 0; e < 8; ++e) acc[e] = 0.f;
    for (int j = 0; j < cnt; ++j) { const uint4 raw = *(const uint4*)(proj + (size_t)(row - j) * IN_COLS + COL_U + ch0);
        acc[0] += __uint_as_float(raw.x << 16); acc[1] += __uint_as_float(raw.x & 0xffff0000u); acc[2] += __uint_as_float(raw.y << 16); acc[3] += __uint_as_float(raw.y & 0xffff0000u);
        acc[4] += __uint_as_float(raw.z << 16); acc[5] += __uint_as_float(raw.z & 0xffff0000u); acc[6] += __uint_as_float(raw.w << 16); acc[7] += __uint_as_float(raw.w & 0xffff0000u); }
    const uint4 raw = *(const uint4*)(proj + (size_t)row * IN_COLS + COL_U + ch0);
    const float u[8] = {__uint_as_float(raw.x << 16), __uint_as_float(raw.x & 0xffff0000u), __uint_as_float(raw.y << 16), __uint_as_float(raw.y & 0xffff0000u),
                        __uint_as_float(raw.z << 16), __uint_as_float(raw.z & 0xffff0000u), __uint_as_float(raw.w << 16), __uint_as_float(raw.w & 0xffff0000u)};
    const float ic = 1.f / (float)cnt;
    bf16_t* o = Dg + ((size_t)g * NTOK + row) * B_GD + (ch0 % B_GD);
#pragma unroll
    for (int e = 0; e < 8; ++e) o[e] = f2bf(acc[e] * ic - u[e]);
}

__global__ void __launch_bounds__(256) k_pool_fin(const float* __restrict__ Yb, const bf16_t* __restrict__ proj, const float* __restrict__ pool_scale, bf16_t* __restrict__ ycat) {
    const int row = blockIdx.x;
    for (int ch = threadIdx.x; ch < B_WIDTH; ch += 256) { const int g = ch / B_GD;
        const float y = Yb[((size_t)g * NTOK + row) * B_GD + (ch % B_GD)] * pool_scale[ch] * silu_f(bf2f(proj[(size_t)row * IN_COLS + COL_GB + ch]));
        ycat[(size_t)row * D_MODEL + A_WIDTH + ch] = f2bf(y); }
}

__global__ void __launch_bounds__(256) k_post1(const float* __restrict__ x, const float* __restrict__ y, const float* __restrict__ g1, const float* __restrict__ g2,
                                               float* __restrict__ x1, bf16_t* __restrict__ h2) {
    __shared__ float red[8];
    const size_t off = (size_t)blockIdx.x * D_MODEL;
    float4 v[4]; float ss = 0.f;
#pragma unroll
    for (int j = 0; j < 4; ++j) { v[j] = *(const float4*)(y + off + j * 1024 + threadIdx.x * 4); ss += v[j].x * v[j].x + v[j].y * v[j].y + v[j].z * v[j].z + v[j].w * v[j].w; }
    ss = wave_sum_f(ss);
    if ((threadIdx.x & 63) == 0) red[threadIdx.x >> 6] = ss;
    __syncthreads();
    const float rs = rsqrtf((red[0] + red[1] + red[2] + red[3]) * (1.f / D_MODEL) + EPS);
    float ss2 = 0.f;
#pragma unroll
    for (int j = 0; j < 4; ++j) { const int c = j * 1024 + threadIdx.x * 4; const float4 gg = *(const float4*)(g1 + c); const float4 xx = *(const float4*)(x + off + c);
        v[j].x = xx.x + v[j].x * rs * gg.x; v[j].y = xx.y + v[j].y * rs * gg.y; v[j].z = xx.z + v[j].z * rs * gg.z; v[j].w = xx.w + v[j].w * rs * gg.w;
        *(float4*)(x1 + off + c) = v[j]; ss2 += v[j].x * v[j].x + v[j].y * v[j].y + v[j].z * v[j].z + v[j].w * v[j].w; }
    ss2 = wave_sum_f(ss2);
    if ((threadIdx.x & 63) == 0) red[4 + (threadIdx.x >> 6)] = ss2;
    __syncthreads();
    const float rs2 = rsqrtf((red[4] + red[5] + red[6] + red[7]) * (1.f / D_MODEL) + EPS);
#pragma unroll
    for (int j = 0; j < 4; ++j) { const int c = j * 1024 + threadIdx.x * 4; const float4 gg = *(const float4*)(g2 + c);
        h2[off + c + 0] = f2bf(v[j].x * rs2 * gg.x); h2[off + c + 1] = f2bf(v[j].y * rs2 * gg.y); h2[off + c + 2] = f2bf(v[j].z * rs2 * gg.z); h2[off + c + 3] = f2bf(v[j].w * rs2 * gg.w); }
}

__global__ void __launch_bounds__(256) k_post2(const float* __restrict__ x1, const float* __restrict__ z, const float* __restrict__ g, float* __restrict__ out) {
    __shared__ float red[4];
    const size_t off = (size_t)blockIdx.x * D_MODEL;
    float4 v[4]; float ss = 0.f;
#pragma unroll
    for (int j = 0; j < 4; ++j) { v[j] = *(const float4*)(z + off + j * 1024 + threadIdx.x * 4); ss += v[j].x * v[j].x + v[j].y * v[j].y + v[j].z * v[j].z + v[j].w * v[j].w; }
    ss = wave_sum_f(ss);
    if ((threadIdx.x & 63) == 0) red[threadIdx.x >> 6] = ss;
    __syncthreads();
    const float rs = rsqrtf((red[0] + red[1] + red[2] + red[3]) * (1.f / D_MODEL) + EPS);
#pragma unroll
    for (int j = 0; j < 4; ++j) { const int c = j * 1024 + threadIdx.x * 4; const float4 gg = *(const float4*)(g + c); const float4 xx = *(const float4*)(x1 + off + c);
        float4 o; o.x = xx.x + v[j].x * rs * gg.x; o.y = xx.y + v[j].y * rs * gg.y; o.z = xx.z + v[j].z * rs * gg.z; o.w = xx.w + v[j].w * rs * gg.w;
        *(float4*)(out + off + c) = o; }
}

__global__ void __launch_bounds__(256) k_xattn_naive(const float* __restrict__ Q, const float* __restrict__ KX, const float* __restrict__ VX, bf16_t* __restrict__ O) {
    __shared__ float qs[4][256];
    __shared__ float ps[4][256];
    const int row = blockIdx.x, b = row / SEQ, head = threadIdx.x >> 6, lane = threadIdx.x & 63;
#pragma unroll
    for (int j = 0; j < 4; ++j) qs[head][lane + 64 * j] = Q[(size_t)row * XA_WIDTH + head * XA_HD + lane + 64 * j] * 0.0625f;
    __syncthreads();
    float s[4]; float mx = -3.0e38f;
#pragma unroll
    for (int j = 0; j < 4; ++j) { const int m = lane + 64 * j; const float* kp = KX + ((size_t)b * N_MEM + m) * XA_WIDTH + head * XA_HD; float dot = 0.f;
#pragma unroll 4
        for (int d = 0; d < XA_HD; d += 4) { const float4 kk = *(const float4*)(kp + d); dot += qs[head][d] * kk.x + qs[head][d + 1] * kk.y + qs[head][d + 2] * kk.z + qs[head][d + 3] * kk.w; }
        s[j] = dot; mx = fmaxf(mx, dot); }
    mx = wave_max_f(mx);
    float l = 0.f;
#pragma unroll
    for (int j = 0; j < 4; ++j) { const float p = __expf(s[j] - mx); ps[head][lane + 64 * j] = p; l += p; }
    l = wave_sum_f(l);
    __syncthreads();
    float4 a = {0.f, 0.f, 0.f, 0.f};
    const float* vp = VX + (size_t)b * N_MEM * XA_WIDTH + head * XA_HD + 4 * lane;
#pragma unroll 4
    for (int m = 0; m < N_MEM; ++m) { const float p = ps[head][m]; const float4 vv = *(const float4*)(vp + (size_t)m * XA_WIDTH); a.x += p * vv.x; a.y += p * vv.y; a.z += p * vv.z; a.w += p * vv.w; }
    const float inv = 1.f / l;
    bf16_t* o = O + (size_t)row * XA_WIDTH + head * XA_HD + 4 * lane;
    o[0] = f2bf(a.x * inv); o[1] = f2bf(a.y * inv); o[2] = f2bf(a.z * inv); o[3] = f2bf(a.w * inv);
}

__global__ void __launch_bounds__(512, 2) k_gemm_f32(const bf16_t* A, const bf16_t* Bt, float* C, int M, int N, int K, int ldc) {
    extern __shared__ __attribute__((aligned(16))) unsigned char lds[];
    pg8::Gemm g; g.A = A; g.Bt = Bt; g.M = M; g.N = N; g.K = K;
    pg8::EpiF32 E; E.C = C; E.ldc = ldc;
    pg8::StaticOrder S; S.init(M, N, (int)gridDim.x, (int)blockIdx.x);
    pg8::gemm_phase<pg8::EpiF32, pg8::StaticOrder, true, true>((PG8_LAS unsigned char*)lds, g, S, E);
}
__global__ void __launch_bounds__(512, 2) k_gemm_bf16(const bf16_t* A, const bf16_t* Bt, bf16_t* C, int M, int N, int K, int ldc) {
    extern __shared__ __attribute__((aligned(16))) unsigned char lds[];
    pg8::Gemm g; g.A = A; g.Bt = Bt; g.M = M; g.N = N; g.K = K;
    pg8::EpiBf16<0> E; E.O = C; E.ldc = ldc; E.bias = nullptr; E.split_cols = 0; E.split_stride = 0; E.scale0 = 1.f;
    pg8::StaticOrder S; S.init(M, N, (int)gridDim.x, (int)blockIdx.x);
    pg8::gemm_phase<pg8::EpiBf16<0>, pg8::StaticOrder, true, true>((PG8_LAS unsigned char*)lds, g, S, E);
}

constexpr size_t MiB = 1u << 20;
constexpr size_t WS_WINT = 2 * MiB, WS_WOUTT = 98 * MiB, WS_WXQT = 130 * MiB, WS_WXKT = 138 * MiB, WS_WXVT = 146 * MiB, WS_WXOT = 154 * MiB, WS_WPT = 162 * MiB;
constexpr size_t WS_H = 164 * MiB, WS_MN = 228 * MiB, WS_PROJ = 236 * MiB, WS_YCAT = 428 * MiB, WS_Y = 492 * MiB, WS_X1 = 620 * MiB, WS_END = 748 * MiB;
constexpr size_t WS_DG = WS_Y;
constexpr size_t WS_YB = WS_Y + 32 * MiB;
constexpr size_t WS_Q = WS_PROJ, WS_KX = WS_PROJ + 32 * MiB, WS_VX = WS_PROJ + 36 * MiB, WS_O = WS_PROJ + 40 * MiB, WS_Z = WS_PROJ + 56 * MiB;

extern "C" void kernel_launch(void* const* d_in, const int* in_sizes, int n_in, void* d_out, int out_size, void* d_ws, size_t ws_size, hipStream_t stream) {
    static int ready = 0;
    if (!ready) {
        if (n_in != 16 || in_sizes[0] != NTOK * D_MODEL || out_size != NTOK * D_MODEL || ws_size < WS_END) { fprintf(stderr, "kernel_launch: unexpected shapes (n_in %d, ws %zu)\n", n_in, ws_size); ready = -1; return; }
        (void)hipFuncSetAttribute((const void*)k_gemm_f32, hipFuncAttributeMaxDynamicSharedMemorySize, pg8::STAGE_BYTES);
        (void)hipFuncSetAttribute((const void*)k_gemm_bf16, hipFuncAttributeMaxDynamicSharedMemorySize, pg8::STAGE_BYTES);
        ready = 1;
    }
    if (ready < 0) return;
    const float* x = (const float*)d_in[0]; const float* mem = (const float*)d_in[1]; const float* g_mix_pre = (const float*)d_in[2]; const float* w_in = (const float*)d_in[3];
    const float* rel_bias = (const float*)d_in[4]; const float* w_pool = (const float*)d_in[5]; const float* pool_scale = (const float*)d_in[6]; const float* w_out = (const float*)d_in[7];
    const float* g_mix_post = (const float*)d_in[8]; const float* g_xa_pre = (const float*)d_in[9]; const float* g_mem = (const float*)d_in[10]; const float* w_xq = (const float*)d_in[11];
    const float* w_xk = (const float*)d_in[12]; const float* w_xv = (const float*)d_in[13]; const float* w_xo = (const float*)d_in[14]; const float* g_xa_post = (const float*)d_in[15];
    unsigned char* ws = (unsigned char*)d_ws; float* out = (float*)d_out;
    bf16_t* WinT = (bf16_t*)(ws + WS_WINT); bf16_t* WoutT = (bf16_t*)(ws + WS_WOUTT); bf16_t* WxqT = (bf16_t*)(ws + WS_WXQT); bf16_t* WxkT = (bf16_t*)(ws + WS_WXKT);
    bf16_t* WxvT = (bf16_t*)(ws + WS_WXVT); bf16_t* WxoT = (bf16_t*)(ws + WS_WXOT); bf16_t* WpT = (bf16_t*)(ws + WS_WPT);
    bf16_t* H = (bf16_t*)(ws + WS_H); bf16_t* Mn = (bf16_t*)(ws + WS_MN); bf16_t* PROJ = (bf16_t*)(ws + WS_PROJ); bf16_t* YCAT = (bf16_t*)(ws + WS_YCAT);
    float* Y = (float*)(ws + WS_Y); float* X1 = (float*)(ws + WS_X1); bf16_t* Dg = (bf16_t*)(ws + WS_DG); float* Yb = (float*)(ws + WS_YB);
    float* Q = (float*)(ws + WS_Q); float* KX = (float*)(ws + WS_KX); float* VX = (float*)(ws + WS_VX); bf16_t* O = (bf16_t*)(ws + WS_O); float* Z = (float*)(ws + WS_Z);

    k_transpose_bf16<<<dim3(IN_COLS / 32, D_MODEL / 32), 256, 0, stream>>>(w_in, WinT, D_MODEL, IN_COLS);
    k_transpose_bf16<<<dim3(D_MODEL / 32, D_MODEL / 32), 256, 0, stream>>>(w_out, WoutT, D_MODEL, D_MODEL);
    k_transpose_bf16<<<dim3(XA_WIDTH / 32, D_MODEL / 32), 256, 0, stream>>>(w_xq, WxqT, D_MODEL, XA_WIDTH);
    k_transpose_bf16<<<dim3(XA_WIDTH / 32, D_MODEL / 32), 256, 0, stream>>>(w_xk, WxkT, D_MODEL, XA_WIDTH);
    k_transpose_bf16<<<dim3(XA_WIDTH / 32, D_MODEL / 32), 256, 0, stream>>>(w_xv, WxvT, D_MODEL, XA_WIDTH);
    k_transpose_bf16<<<dim3(D_MODEL / 32, XA_WIDTH / 32), 256, 0, stream>>>(w_xo, WxoT, XA_WIDTH, D_MODEL);
    for (int g = 0; g < B_GROUPS; ++g)
        k_transpose_bf16<<<dim3(B_GD / 32, B_GD / 32), 256, 0, stream>>>(w_pool + (size_t)g * B_GD * B_GD, WpT + (size_t)g * B_GD * B_GD, B_GD, B_GD);
    k_rmsnorm_bf16<<<NTOK, 256, 0, stream>>>(x, g_mix_pre, H);
    k_rmsnorm_bf16<<<NMTOK, 256, 0, stream>>>(mem, g_mem, Mn);
    k_gemm_bf16<<<256, 512, pg8::STAGE_BYTES, stream>>>(H, WinT, PROJ, NTOK, IN_COLS, D_MODEL, IN_COLS);
    k_attn_naive<<<BATCH * NCHUNK * A_HEADS, 256, 0, stream>>>(PROJ, rel_bias, YCAT);
    k_pool_d<<<NTOK, 256, 0, stream>>>(PROJ, Dg);
    for (int g = 0; g < B_GROUPS; ++g)
        k_gemm_f32<<<256, 512, pg8::STAGE_BYTES, stream>>>(Dg + (size_t)g * NTOK * B_GD, WpT + (size_t)g * B_GD * B_GD, Yb + (size_t)g * NTOK * B_GD, NTOK, B_GD, B_GD, B_GD);
    k_pool_fin<<<NTOK, 256, 0, stream>>>(Yb, PROJ, pool_scale, YCAT);
    k_gemm_f32<<<256, 512, pg8::STAGE_BYTES, stream>>>(YCAT, WoutT, Y, NTOK, D_MODEL, D_MODEL, D_MODEL);
    k_post1<<<NTOK, 256, 0, stream>>>(x, Y, g_mix_post, g_xa_pre, X1, H);
    k_gemm_f32<<<256, 512, pg8::STAGE_BYTES, stream>>>(H, WxqT, Q, NTOK, XA_WIDTH, D_MODEL, XA_WIDTH);
    k_gemm_f32<<<256, 512, pg8::STAGE_BYTES, stream>>>(Mn, WxkT, KX, NMTOK, XA_WIDTH, D_MODEL, XA_WIDTH);
    k_gemm_f32<<<256, 512, pg8::STAGE_BYTES, stream>>>(Mn, WxvT, VX, NMTOK, XA_WIDTH, D_MODEL, XA_WIDTH);
    k_xattn_naive<<<NTOK, 256, 0, stream>>>(Q, KX, VX, O);
    k_gemm_f32<<<256, 512, pg8::STAGE_BYTES, stream>>>(O, WxoT, Z, NTOK, D_MODEL, XA_WIDTH, D_MODEL);
    k_post2<<<NTOK, 256, 0, stream>>>(X1, Z, g_xa_post, out);
}
```

```cpp
#include <hip/hip_runtime.h>
#include <cstdio>
#include <cstdint>
#define LAS __attribute__((address_space(3)))
typedef unsigned short bf16_t;
typedef short bf16x8 __attribute__((ext_vector_type(8)));
typedef float f32x4 __attribute__((ext_vector_type(4)));
typedef unsigned u32x4 __attribute__((ext_vector_type(4)));
typedef float f32x16 __attribute__((ext_vector_type(16)));
namespace pg8 {
constexpr int BM = 256, BK = 64, HALF = 128, HTB = HALF * BK * 2  , STAGE_BYTES = 8 * HTB;

__host__ __device__ __forceinline__ int lds_byte(int r, int c) { const int st = (r >> 4) * 2 + (c >> 5), rr = r & 15, cc = c & 31, ob = rr * 64 + cc * 2; return st * 1024 + (ob ^ (((ob >> 9) & 1) << 5)); }
__host__ __device__ __forceinline__ void stage_rc(int b, int& R, int& C) { const int st = b / 1024, sb = b % 1024, swz = sb ^ (((sb >> 9) & 1) << 5); R = (st >> 1) * 16 + swz / 64; C = (st & 1) * 32 + (swz % 64) / 2; }
__host__ __device__ __forceinline__ int perm_slot(int perm, int rho) {
    const int n = rho >> 4, i = rho & 15;
    if (perm == 1) return 8 * (i >> 2) + 4 * n + (i & 3);
    if (perm == 2) return 16 * (i >> 3) + 8 * n + 4 * ((i >> 2) & 1) + (i & 3);
    return rho;
}
struct Unit { const char* A; const char* B; int pm, pn, kind, perm; };
struct Geom { int K, lda, ldb; };

__device__ __forceinline__ unsigned cvt_pk_bf16(float lo, float hi) { unsigned r; asm volatile("v_cvt_pk_bf16_f32 %0, %1, %2" : "=v"(r) : "v"(lo), "v"(hi)); return r; }

template <class Epi, class Sched>
__device__ __forceinline__ void gemm_phase(LAS unsigned char* lds, const Geom g, const Sched& S, const Epi& E) {
    int tid_ = threadIdx.x; asm volatile("" : "+v"(tid_));
    const int tid = tid_, wid = __builtin_amdgcn_readfirstlane(tid >> 6), lane = tid & 63, wr = wid >> 2, wc = wid & 3, fr = lane & 15, fq = lane >> 4;
    const int K = g.K, nt = K / BK;
    int sR[2], sC[2];
#pragma unroll
    for (int i = 0; i < 2; ++i) stage_rc(tid * 16 + i * 8192, sR[i], sC[i]);
    unsigned voffA[2];
#pragma unroll
    for (int i = 0; i < 2; ++i) voffA[i] = (unsigned)(sR[i] * g.lda + sC[i]) * 2u;
#define PG8_SET_VOFFB(dst, prm) do { _Pragma("unroll") for (int _i = 0; _i < 2; ++_i) { const int _R = sR[_i]; const int _Rb = (_R & ~31) + perm_slot((prm), _R & 31); (dst)[_i] = (unsigned)(_Rb * g.ldb + sC[_i]) * 2u; } } while (0)
    const size_t kstep = (size_t)(BK * 2);
    const size_t hstepA = (size_t)HALF * g.lda * 2, hstepB = (size_t)HALF * g.ldb * 2;
    const unsigned ldsw = (unsigned)wid * 1024u;
    const int aoff = lds_byte(wr * 64 + fr, fq * 8), boff = lds_byte(wc * 32 + fr, fq * 8);
#define PG8_SA(b, h) (((b) * 2 + (h)) * HTB)
#define PG8_SB(b, h) ((4 + (b) * 2 + (h)) * HTB)
#define PG8_STAGE(bufoff, gbase, voff) do { _Pragma("unroll") for (int _i = 0; _i < 2; ++_i) \
        __builtin_amdgcn_global_load_lds((const unsigned*)((const char*)(gbase) + (voff)[_i]), (LAS unsigned*)(lds + (bufoff) + ldsw + _i * 8192), 16, 0, 0); } while (0)
#define PG8_LDA(dst, b, h) do { _Pragma("unroll") for (int m = 0; m < 4; ++m) _Pragma("unroll") for (int k = 0; k < 2; ++k) dst[m][k] = *(const LAS bf16x8*)(lds + PG8_SA(b, h) + aoff + m * 2048 + k * 1024); } while (0)
#define PG8_LDB(dst, b, h) do { _Pragma("unroll") for (int n = 0; n < 2; ++n) _Pragma("unroll") for (int k = 0; k < 2; ++k) dst[n][k] = *(const LAS bf16x8*)(lds + PG8_SB(b, h) + boff + n * 2048 + k * 1024); } while (0)
#define PG8_MMA(ai, bj, At, Bt) do { __builtin_amdgcn_s_setprio(1); _Pragma("unroll") for (int m = 0; m < 4; ++m) _Pragma("unroll") for (int n = 0; n < 2; ++n) _Pragma("unroll") for (int k = 0; k < 2; ++k) \
        acc[ai][bj][m][n] = __builtin_amdgcn_mfma_f32_16x16x32_bf16(Bt[n][k], At[m][k], acc[ai][bj][m][n], 0, 0, 0); __builtin_amdgcn_s_setprio(0); } while (0)
#define PG8_WAIT_V(n) asm volatile("s_waitcnt vmcnt(" #n ")" ::: "memory")
#define PG8_WAIT_L(n) asm volatile("s_waitcnt lgkmcnt(" #n ")" ::: "memory")
#define PG8_BAR __builtin_amdgcn_s_barrier()
#define PG8_SCHED __builtin_amdgcn_sched_barrier(0)
    Unit cur, nxt; int ui = 0;
    if (!S.next(0, cur)) return;
    f32x4 acc[2][2][4][2];
#pragma unroll
    for (int a = 0; a < 2; ++a)
#pragma unroll
        for (int b = 0; b < 2; ++b)
#pragma unroll
            for (int m = 0; m < 4; ++m)
#pragma unroll
                for (int n = 0; n < 2; ++n) acc[a][b][m][n] = (f32x4){0.f, 0.f, 0.f, 0.f};
    bf16x8 At[4][2], B0[2][2], B1[2][2];
    unsigned vBc[2], vBn[2];
    PG8_SET_VOFFB(vBc, cur.perm);
    const char* cA = cur.A; const char* cB = cur.B;
    PG8_STAGE(PG8_SB(0, 0), cB, vBc); PG8_STAGE(PG8_SB(0, 1), cB + hstepB, vBc); PG8_STAGE(PG8_SA(0, 0), cA, voffA); PG8_STAGE(PG8_SA(0, 1), cA + hstepA, voffA);
    if (wr == 1) PG8_BAR;
    PG8_WAIT_V(2); PG8_BAR;
    PG8_STAGE(PG8_SB(1, 0), cB + kstep, vBc); PG8_STAGE(PG8_SA(1, 0), cA + kstep, voffA); PG8_STAGE(PG8_SB(1, 1), cB + hstepB + kstep, vBc);
    PG8_WAIT_V(6); PG8_BAR;
    for (;;) {
        const bool has_next = S.next(ui + 1, nxt);
        const char* nA = has_next ? nxt.A : cA; const char* nB = has_next ? nxt.B : cB;
        if (has_next) { PG8_SET_VOFFB(vBn, nxt.perm); } else { vBn[0] = vBc[0]; vBn[1] = vBc[1]; }
        asm volatile(".p2align 6");
        for (int t = 0; t < nt; t += 2) {
            const bool last = (t == nt - 2);
            const char* a1 = cA + (size_t)(t + 1) * kstep;
            const char* a2 = last ? nA : cA + (size_t)(t + 2) * kstep; const char* b2 = last ? nB : cB + (size_t)(t + 2) * kstep;
            const char* a3 = a2 + kstep; const char* b3 = b2 + kstep;
            unsigned vB2[2]; vB2[0] = last ? vBn[0] : vBc[0]; vB2[1] = last ? vBn[1] : vBc[1];
            PG8_LDB(B0, 0, 0); PG8_LDB(B1, 0, 1); PG8_SCHED; PG8_LDA(At, 0, 0); PG8_STAGE(PG8_SA(1, 1), a1 + hstepA, voffA);
            PG8_WAIT_V(8); PG8_WAIT_L(0); PG8_BAR; PG8_MMA(0, 0, At, B0); PG8_MMA(0, 1, At, B1); PG8_BAR; PG8_SCHED;
            PG8_LDA(At, 0, 1); PG8_STAGE(PG8_SB(0, 0), b2, vB2); PG8_STAGE(PG8_SB(0, 1), b2 + hstepB, vB2); PG8_STAGE(PG8_SA(0, 0), a2, voffA);
            PG8_WAIT_V(8); PG8_WAIT_L(0); PG8_BAR; PG8_MMA(1, 0, At, B0); PG8_MMA(1, 1, At, B1); PG8_BAR; PG8_SCHED;
            PG8_LDB(B0, 1, 0); PG8_LDB(B1, 1, 1); PG8_SCHED; PG8_LDA(At, 1, 0); PG8_STAGE(PG8_SA(0, 1), a2 + hstepA, voffA);
            PG8_WAIT_V(8); PG8_WAIT_L(0); PG8_BAR; PG8_MMA(0, 0, At, B0); PG8_MMA(0, 1, At, B1); PG8_BAR; PG8_SCHED;
            PG8_LDA(At, 1, 1); PG8_STAGE(PG8_SB(1, 0), b3, vB2); PG8_STAGE(PG8_SB(1, 1), b3 + hstepB, vB2); PG8_STAGE(PG8_SA(1, 0), a3, voffA);
            PG8_WAIT_V(8); PG8_WAIT_L(0); PG8_BAR; PG8_MMA(1, 0, At, B0); PG8_MMA(1, 1, At, B1); PG8_BAR; PG8_SCHED;
        }
        if (wr == 0) PG8_BAR;
        E(acc, cur, wr, wc, fr, fq);
        if (!has_next) break;
#pragma unroll
        for (int a = 0; a < 2; ++a)
#pragma unroll
            for (int b = 0; b < 2; ++b)
#pragma unroll
                for (int m = 0; m < 4; ++m)
#pragma unroll
                    for (int n = 0; n < 2; ++n) acc[a][b][m][n] = (f32x4){0.f, 0.f, 0.f, 0.f};
        cur = nxt; cA = nA; cB = nB; vBc[0] = vBn[0]; vBc[1] = vBn[1]; ++ui;
        if (wr == 1) PG8_BAR;
    }
    PG8_WAIT_V(0);
    PG8_BAR;
#undef PG8_SET_VOFFB
#undef PG8_SA
#undef PG8_SB
#undef PG8_STAGE
#undef PG8_LDA
#undef PG8_LDB
#undef PG8_MMA
#undef PG8_WAIT_V
#undef PG8_WAIT_L
#undef PG8_BAR
#undef PG8_SCHED
}
}

constexpr int D_MODEL = 4096, BATCH = 4, SEQ = 2048, NTOK = BATCH * SEQ;
constexpr int CHUNK = 64, NCHUNK = SEQ / CHUNK, A_WIDTH = 2048, A_HD = 128, A_HEADS = 16, REL_SIZE = 192;
constexpr int B_WIDTH = 2048, B_GROUPS = 4, B_GD = 512, IN_COLS = 12288;
constexpr int XA_HEADS = 4, XA_HD = 256, XA_WIDTH = 1024, N_MEM = 256, NMTOK = BATCH * N_MEM;
constexpr float EPS = 1e-6f;
constexpr int COL_Q = 0, COL_K = 2048, COL_V = 4096, COL_GA = 6144, COL_U = 8192, COL_GB = 10240;
constexpr int NWAVES = 8;
#ifndef PROBE_MASK
#define PROBE_MASK 0
#endif

constexpr size_t MiB = 1u << 20;
constexpr size_t WS_CTL = 0, CTL_ZERO_BYTES = 192 * 1024;
constexpr size_t WS_WINT = 2 * MiB, WS_WOUTT = 98 * MiB, WS_WXQT = 130 * MiB, WS_WXKT = 138 * MiB, WS_WXVT = 146 * MiB, WS_WXOT = 154 * MiB, WS_WPT = 162 * MiB;
constexpr size_t WS_H = 164 * MiB, WS_MN = 228 * MiB, WS_QS = 236 * MiB, WS_KF = 268 * MiB, WS_VF = 300 * MiB, WS_GA = 332 * MiB, WS_U = 364 * MiB, WS_GB = 396 * MiB, WS_YCAT = 428 * MiB, WS_Y = 492 * MiB, WS_X1 = 620 * MiB, WS_END = 748 * MiB;
constexpr size_t WS_DSCR = WS_Y;
constexpr size_t WS_QP = 300 * MiB, WS_KXF = 364 * MiB, WS_VXF = 366 * MiB, WS_O = 368 * MiB, WS_XS = WS_H;
constexpr int CW_BAR = 4096;
constexpr int CW_RSS1 = 8192, CW_RSS2 = 16384, CW_RSS3 = 24576;
constexpr int CW_CNT1 = 32768, CW_CNT3 = 36864;
constexpr int CW_F3 = 43520, CW_FKV = 44544;
constexpr int CW_F5 = 40960, CW_F6 = 43008;

constexpr int RING_OFF = 0, RING_BYTES = 131072;
constexpr int LDSCTL_OFF = RING_BYTES, MISC_OFF = LDSCTL_OFF + 320, BIAS_OFF = RING_BYTES + 2048, XCH_OFF = RING_BYTES + 8192;
constexpr int LDS_BYTES = 163840;

__device__ __forceinline__ float bflo(unsigned w) { return __uint_as_float(w << 16); }
__device__ __forceinline__ float bfhi(unsigned w) { return __uint_as_float(w & 0xffff0000u); }
__device__ __forceinline__ unsigned pk2(float lo, float hi) { unsigned r; asm volatile("v_cvt_pk_bf16_f32 %0, %1, %2" : "=v"(r) : "v"(lo), "v"(hi)); return r; }
__device__ __forceinline__ float wave_sum_f(float v) {
#pragma unroll
    for (int o = 32; o > 0; o >>= 1) v += __shfl_xor(v, o);
    return v;
}
#define LDS_WAIT() asm volatile("s_waitcnt lgkmcnt(0)" ::: "memory")
__device__ __forceinline__ void store16_wt(void* p, u32x4 v) { asm volatile("global_store_dwordx4 %0, %1, off sc1\n\ts_nop 1" :: "v"(p), "v"(v) : "memory"); }
__device__ __forceinline__ void store8_wt(void* p, unsigned long long v) { asm volatile("global_store_dwordx2 %0, %1, off sc1\n\ts_nop 1" :: "v"(p), "v"(v) : "memory"); }
__device__ __forceinline__ int launder_i(int v) { asm volatile("" : "+v"(v)); return v; }

#define XB_TMO      128
#define XB_XCNT(j)  (256  + 64 * (j))
#define XB_XSUB(j)  (1280 + 64 * (j))
#define XB_XGEN(j)  (2304 + 64 * (j))
#define XB_TOP      3328
#define XB_TOPGEN   3392
#define XCD_BAR_WORDS 3456
#define XB_SPIN_CAP (1u << 18)
__device__ __forceinline__ unsigned xb_ld(unsigned* p)              { return __hip_atomic_load(p, __ATOMIC_RELAXED, __HIP_MEMORY_SCOPE_AGENT); }
__device__ __forceinline__ unsigned xb_add(unsigned* p, unsigned v) { return __hip_atomic_fetch_add(p, v, __ATOMIC_RELAXED, __HIP_MEMORY_SCOPE_AGENT); }
__device__ __forceinline__ unsigned xb_xcc_id() { return (unsigned)__builtin_amdgcn_s_getreg((3 << 11) | 20) & 0xFu; }
#define XB_SPIN(cond, bar) do { unsigned _sp = 0; while (cond) { __builtin_amdgcn_s_sleep(1); \
    if ((++_sp & 255u) == 0u) { if (xb_ld(&(bar)[XB_TMO])) break; if (_sp > XB_SPIN_CAP) { atomicAdd(&(bar)[XB_TMO], 1u); break; } } } } while (0)
struct XcdBarrier { unsigned* bar; unsigned x; volatile LAS unsigned* st; };
__device__ __forceinline__ XcdBarrier xcd_barrier_post(unsigned* bar, volatile LAS unsigned* st) {
    XcdBarrier b; b.bar = bar; b.x = xb_xcc_id(); b.st = st;
    if (threadIdx.x == 0) (void)xb_add(&bar[XB_XCNT(b.x)], 1u);
    return b;
}
__device__ __forceinline__ void xcd_barrier_complete(unsigned* bar, unsigned x, unsigned& nloc, unsigned& nx) {
    const unsigned G = gridDim.x * gridDim.y * gridDim.z;
    unsigned sum, cnt, mine, sp = 0u;
    for (;;) {
        sum = 0u; cnt = 0u; mine = 0u;
#pragma unroll
        for (unsigned j = 0; j < 16; ++j) { const unsigned c = xb_ld(&bar[XB_XCNT(j)]); sum += c; cnt += (c > 0u) ? 1u : 0u; mine = (j == x) ? c : mine; }
        if (sum == G) break;
        __builtin_amdgcn_s_sleep(1);
        if ((++sp & 255u) == 0u) { if (xb_ld(&bar[XB_TMO])) break; if (sp > XB_SPIN_CAP) { atomicAdd(&bar[XB_TMO], 1u); break; } }
    }
    nloc = mine > 0u ? mine : 1u; nx = cnt > 0u ? cnt : 1u;
}
__device__ __forceinline__ void xcd_barrier(const XcdBarrier& b) {
    asm volatile("s_waitcnt vmcnt(0)" ::: "memory");
    __syncthreads();
    if (threadIdx.x == 0) {
        unsigned* bar = b.bar;
        __builtin_amdgcn_s_waitcnt(0);
        unsigned nloc = b.st[0], nx = b.st[1];
        if (nloc == 0u) { xcd_barrier_complete(bar, b.x, nloc, nx); b.st[0] = nloc; b.st[1] = nx; }
        const unsigned old = xb_add(&bar[XB_XSUB(b.x)], 1u);
        const unsigned gen = old / nloc;
        if (old + 1u == (gen + 1u) * nloc) {
            __builtin_amdgcn_fence(__ATOMIC_RELEASE, "agent");
            asm volatile("s_waitcnt vmcnt(0)" ::: "memory");
            const unsigned og = xb_add(&bar[XB_TOP], 1u);
            const unsigned tg = og / nx;
            if (og + 1u == (tg + 1u) * nx) xb_add(&bar[XB_TOPGEN], 1u);
            else XB_SPIN(xb_ld(&bar[XB_TOPGEN]) == tg, bar);
            __builtin_amdgcn_fence(__ATOMIC_ACQUIRE, "agent");
            xb_add(&bar[XB_XGEN(b.x)], 1u);
            asm volatile("s_waitcnt vmcnt(0)" ::: "memory");
        } else {
            XB_SPIN(xb_ld(&bar[XB_XGEN(b.x)]) == gen, bar);
            __builtin_amdgcn_fence(__ATOMIC_ACQUIRE, "agent");
            asm volatile("s_waitcnt vmcnt(0)" ::: "memory");
        }
    }
    __syncthreads();
}

__device__ __forceinline__ void handoff_signal(unsigned* f) {
    asm volatile("s_waitcnt vmcnt(0)" ::: "memory");
    __syncthreads();
    if (threadIdx.x == 0) (void)xb_add(f, 1u);
}
__device__ __forceinline__ void handoff_wait(unsigned* f, unsigned target, unsigned* bar) {
    if (threadIdx.x == 0) { XB_SPIN(xb_ld(f) < target, bar); __builtin_amdgcn_fence(__ATOMIC_ACQUIRE, "agent"); asm volatile("s_waitcnt vmcnt(0)" ::: "memory"); }
    __syncthreads();
}

struct Order2 { int pm, pn; };
struct StaticOrder {
    int nM, nN, nwg, G, c;
    __device__ void init(int M, int N, int G_, int c_) { nM = M / 256; nN = N / 256; nwg = nM * nN; G = G_; c = c_; }
    __device__ bool next(int i, Order2& u) const {
        const long L = (long)i * G + c; if (L >= nwg) return false;
        int wgid = (int)L; { const int q = nwg / 8, r = nwg % 8, xcd = wgid % 8, off = wgid / 8; wgid = (xcd < r ? xcd * (q + 1) : r * (q + 1) + (xcd - r) * q) + off; }
        const int nig = 8 * nN, gid = wgid / nig, fm = gid * 8, gsz = (nM - fm) < 8 ? (nM - fm) : 8;
        u.pm = fm + ((wgid % nig) % gsz); u.pn = (wgid % nig) / gsz; return true;
    }
};
struct PanelSched {
    const char* A; const char* B; size_t a_tile, b_tile; int G, c, perm;
    __device__ __forceinline__ bool next(int i, pg8::Unit& u) const {
        if (i >= 2 || G != 256) return false;
        const int x = c & 7, j = c >> 3, pm = 16 * i + 4 * (x >> 1) + (j >> 3), pn = 8 * (x & 1) + (j & 7);
        u.A = A + (size_t)pm * a_tile; u.B = B + (size_t)pn * b_tile; u.pm = pm; u.pn = pn; u.kind = 0; u.perm = perm; return true;
    }
};
struct PoolSched {
    const bf16_t* Dscr; const bf16_t* WpT; int G, c;
    __device__ __forceinline__ bool next(int i, pg8::Unit& u) const {
        const int L = i * G + c; if (L >= 256) return false;
        const int g = L >> 6, pn = (L >> 5) & 1, pm = L & 31;
        u.A = (const char*)(Dscr + (size_t)L * 256 * B_GD); u.B = (const char*)(WpT + ((size_t)g * B_GD + pn * 256) * B_GD);
        u.pm = pm; u.pn = pn; u.kind = g; u.perm = 1; return true;
    }
};
struct EpiPool {
    const float* pool_scale; const bf16_t* GB; bf16_t* YCAT;
    __device__ __forceinline__ void operator()(const f32x4 (&acc)[2][2][4][2], const pg8::Unit& u, int wr, int wc, int fr, int fq) const {
        const int row0 = u.pm * 256 + wr * 64 + fr, col0 = u.kind * B_GD + u.pn * 256 + wc * 32 + 8 * fq;
        f32x4 sc[2][2];
#pragma unroll
        for (int bj = 0; bj < 2; ++bj) { sc[bj][0] = *(const f32x4*)(pool_scale + col0 + bj * 128); sc[bj][1] = *(const f32x4*)(pool_scale + col0 + bj * 128 + 4); }
#pragma unroll
        for (int ai = 0; ai < 2; ++ai) {
            u32x4 grs[4][2];
#pragma unroll
            for (int m = 0; m < 4; ++m)
#pragma unroll
                for (int bj = 0; bj < 2; ++bj) grs[m][bj] = *(const u32x4*)(GB + (size_t)(row0 + ai * 128 + m * 16) * B_WIDTH + col0 + bj * 128);
#pragma unroll
            for (int m = 0; m < 4; ++m) { const size_t row = (size_t)(row0 + ai * 128 + m * 16);
#pragma unroll
                for (int bj = 0; bj < 2; ++bj) { const u32x4 gr = grs[m][bj];
                    const f32x4 v0 = acc[ai][bj][m][0] * sc[bj][0], v1 = acc[ai][bj][m][1] * sc[bj][1];
                    u32x4 w; w.x = pg8::cvt_pk_bf16(v0[0] * bflo(gr.x), v0[1] * bfhi(gr.x)); w.y = pg8::cvt_pk_bf16(v0[2] * bflo(gr.y), v0[3] * bfhi(gr.y));
                    w.z = pg8::cvt_pk_bf16(v1[0] * bflo(gr.z), v1[1] * bfhi(gr.z)); w.w = pg8::cvt_pk_bf16(v1[2] * bflo(gr.w), v1[3] * bfhi(gr.w));
                    *(u32x4*)(YCAT + row * D_MODEL + A_WIDTH + col0 + bj * 128) = w; } } }
    }
};
struct XkvSched {
    const bf16_t* Mn; const bf16_t* WxkvT; int G, c;
    __device__ __forceinline__ bool next(int i, pg8::Unit& u) const {
        const int L = i * G + c; if (L >= 256) return false;
        const int ks = L & 7, pn = (L >> 3) & 7, pm = L >> 6;
        const char* mrows = (const char*)(Mn + (size_t)pm * 256 * D_MODEL + ks * 512); const char* wrows = (const char*)(WxkvT + (size_t)pn * 256 * D_MODEL + ks * 512);
        if (pn < 4) { u.A = mrows; u.B = wrows; u.perm = 1; } else { u.A = wrows; u.B = mrows; u.perm = 0; }
        u.pm = pm; u.pn = pn; u.kind = ks; return true;
    }
};
__device__ __forceinline__ size_t kxf_index(int b, int hd, int kb16, int ks) { return ((((size_t)(b * XA_HEADS + hd) * 16 + kb16) * 8 + ks) * 64) * 8; }
__device__ __forceinline__ size_t vxf_index(int b, int hd, int kstep, int db) { return ((((size_t)(b * XA_HEADS + hd) * 8 + kstep) * 16 + db) * 64) * 8; }
constexpr size_t XF_ELEMS = (size_t)BATCH * XA_HEADS * 16 * 8 * 64 * 8;
struct XkvEpi {
    bf16_t* XS;
    __device__ __forceinline__ void operator()(const f32x4 (&acc)[2][2][4][2], const pg8::Unit& u, int wr, int wc, int fr, int fq) const {
        bf16_t* slab = XS + (size_t)u.kind * (2 * XF_ELEMS);
        if (u.pn < 4) {
#pragma unroll
            for (int ai = 0; ai < 2; ++ai)
#pragma unroll
                for (int m = 0; m < 4; ++m) { const int tok = u.pm * 256 + ai * 128 + wr * 64 + m * 16 + fr, b = tok >> 8, key = tok & 255;
#pragma unroll
                    for (int bj = 0; bj < 2; ++bj) { const int dcol = bj * 128 + wc * 32;
                        bf16_t* p = slab + kxf_index(b, u.pn, key >> 4, dcol >> 5) + ((key & 15) + 16 * fq) * 8;
                        const f32x4 v0 = acc[ai][bj][m][0], v1 = acc[ai][bj][m][1];
                        u32x4 w; w.x = pg8::cvt_pk_bf16(v0[0], v0[1]); w.y = pg8::cvt_pk_bf16(v0[2], v0[3]); w.z = pg8::cvt_pk_bf16(v1[0], v1[1]); w.w = pg8::cvt_pk_bf16(v1[2], v1[3]);
                        *(u32x4*)p = w; } }
        } else {
#pragma unroll
            for (int ai = 0; ai < 2; ++ai)
#pragma unroll
                for (int m = 0; m < 4; ++m) { const int d = ai * 128 + wr * 64 + m * 16 + fr;
#pragma unroll
                    for (int bj = 0; bj < 2; ++bj) { const int tok0 = u.pm * 256 + bj * 128 + wc * 32, b = tok0 >> 8, kstep = (tok0 & 255) >> 5;
                        bf16_t* p = slab + XF_ELEMS + vxf_index(b, u.pn - 4, kstep, d >> 4) + ((d & 15) + 16 * fq) * 8;
                        const f32x4 v0 = acc[ai][bj][m][0], v1 = acc[ai][bj][m][1];
                        u32x4 w; w.x = pg8::cvt_pk_bf16(v0[0], v0[1]); w.y = pg8::cvt_pk_bf16(v0[2], v0[3]); w.z = pg8::cvt_pk_bf16(v1[0], v1[1]); w.w = pg8::cvt_pk_bf16(v1[2], v1[3]);
                        *(u32x4*)p = w; } }
        }
    }
};
struct QSplitSched {
    const bf16_t* H2; const bf16_t* WxqT; int G, c;
    __device__ __forceinline__ bool next(int i, pg8::Unit& u) const {
        const int L = i * G + c; if (L >= 256) return false;
        const int x = L & 7, j = L >> 3, pm = 4 * x + (j >> 3), pn = (j >> 1) & 3, ks = j & 1;
        u.A = (const char*)(H2 + (size_t)pm * 256 * D_MODEL + ks * 2048); u.B = (const char*)(WxqT + (size_t)pn * 256 * D_MODEL + ks * 2048);
        u.pm = pm; u.pn = pn; u.kind = ks; u.perm = 1; return true;
    }
};
__device__ __forceinline__ void panel_rowss_exchange(const float (&ps)[2][4], float (&tot)[2][4], float* rss, unsigned* cnt, int pm, int wr, int wc, int fr, int fq, LAS float* xl) {
    LAS float* P = xl; LAS float* T = xl + 1024;
    const int wid = wr * 4 + wc, lane = fq * 16 + fr, tid = wid * 64 + lane, rloc = wr * 64 + fr;
    if (fq == 0) {
#pragma unroll
        for (int ai = 0; ai < 2; ++ai)
#pragma unroll
            for (int m = 0; m < 4; ++m) P[wc * 256 + rloc + ai * 128 + m * 16] = ps[ai][m];
    }
    asm volatile("s_waitcnt lgkmcnt(0)" ::: "memory"); __builtin_amdgcn_s_barrier(); asm volatile("" ::: "memory");
    if (tid < 256) atomicAdd(rss + pm * 256 + tid, (P[tid] + P[256 + tid]) + (P[512 + tid] + P[768 + tid]));
    asm volatile("s_waitcnt vmcnt(0) lgkmcnt(0)" ::: "memory"); __builtin_amdgcn_s_barrier(); asm volatile("" ::: "memory");
    if (wid == 0) {
        unsigned* c = cnt + 64 * pm;
        if (lane == 0) __hip_atomic_fetch_add(c, 1u, __ATOMIC_RELAXED, __HIP_MEMORY_SCOPE_AGENT);
        for (unsigned spin = 0; spin < (1u << 22); ++spin) {
            if ((unsigned)__builtin_amdgcn_readfirstlane(__hip_atomic_load(c, __ATOMIC_RELAXED, __HIP_MEMORY_SCOPE_AGENT)) >= 16u) break;
            __builtin_amdgcn_s_sleep(2);
        }
#pragma unroll
        for (int i = 0; i < 4; ++i) T[lane + 64 * i] = __hip_atomic_load(rss + pm * 256 + lane + 64 * i, __ATOMIC_RELAXED, __HIP_MEMORY_SCOPE_AGENT);
    }
    asm volatile("s_waitcnt vmcnt(0) lgkmcnt(0)" ::: "memory"); __builtin_amdgcn_s_barrier(); asm volatile("" ::: "memory");
#pragma unroll
    for (int ai = 0; ai < 2; ++ai)
#pragma unroll
        for (int m = 0; m < 4; ++m) tot[ai][m] = T[rloc + ai * 128 + m * 16];
}
struct EpiOut {
    float* out; const bf16_t* X1b; const float* g; float* rss; unsigned* cnt; LAS float* xl;
    __device__ __forceinline__ void operator()(const f32x4 (&acc)[2][2][4][2], const pg8::Unit& u, int wr, int wc, int fr, int fq) const {
        float ps[2][4], tot[2][4];
#pragma unroll
        for (int ai = 0; ai < 2; ++ai)
#pragma unroll
            for (int m = 0; m < 4; ++m) { float s = 0.f;
#pragma unroll
                for (int bj = 0; bj < 2; ++bj)
#pragma unroll
                    for (int n = 0; n < 2; ++n) { const f32x4 v = acc[ai][bj][m][n]; s += (v[0] * v[0] + v[1] * v[1]) + (v[2] * v[2] + v[3] * v[3]); }
                s += __shfl_xor(s, 16); s += __shfl_xor(s, 32); ps[ai][m] = s; }
        const int row0 = u.pm * 256 + wr * 64 + fr, col0 = u.pn * 256 + wc * 32 + 4 * fq;
        f32x4 gv[2][2]; unsigned long long xpre[4][2][2];
#pragma unroll
        for (int bj = 0; bj < 2; ++bj)
#pragma unroll
            for (int n = 0; n < 2; ++n) gv[bj][n] = *(const f32x4*)(g + col0 + bj * 128 + n * 16);
#pragma unroll
        for (int m = 0; m < 4; ++m)
#pragma unroll
            for (int bj = 0; bj < 2; ++bj)
#pragma unroll
                for (int n = 0; n < 2; ++n) xpre[m][bj][n] = *(const unsigned long long*)(X1b + (size_t)(row0 + m * 16) * D_MODEL + col0 + bj * 128 + n * 16);
        panel_rowss_exchange(ps, tot, rss, cnt, u.pm, wr, wc, fr, fq, xl);
#pragma unroll
        for (int ai = 0; ai < 2; ++ai) {
            unsigned long long xr[4][2][2];
#pragma unroll
            for (int m = 0; m < 4; ++m)
#pragma unroll
                for (int bj = 0; bj < 2; ++bj)
#pragma unroll
                    for (int n = 0; n < 2; ++n) xr[m][bj][n] = (ai == 0) ? xpre[m][bj][n] : *(const unsigned long long*)(X1b + (size_t)(row0 + ai * 128 + m * 16) * D_MODEL + col0 + bj * 128 + n * 16);
#pragma unroll
            for (int m = 0; m < 4; ++m) { const float rs = rsqrtf(tot[ai][m] * (1.f / D_MODEL) + EPS); float* rowp = out + (size_t)(row0 + ai * 128 + m * 16) * D_MODEL + col0;
#pragma unroll
                for (int bj = 0; bj < 2; ++bj)
#pragma unroll
                    for (int n = 0; n < 2; ++n) { const unsigned lo = (unsigned)xr[m][bj][n], hi = (unsigned)(xr[m][bj][n] >> 32); const f32x4 a = acc[ai][bj][m][n], gg = gv[bj][n];
                        f32x4 o; o[0] = bflo(lo) + a[0] * rs * gg[0]; o[1] = bfhi(lo) + a[1] * rs * gg[1]; o[2] = bflo(hi) + a[2] * rs * gg[2]; o[3] = bfhi(hi) + a[3] * rs * gg[3];
                        *(f32x4*)(rowp + bj * 128 + n * 16) = o; } }
        }
    }
};
struct EpiX1 {
    const float* x; const float* g; bf16_t* X1b; float* rss1; unsigned* cnt1; float* rss2; LAS float* xl; unsigned* f3;
    __device__ __forceinline__ void operator()(const f32x4 (&acc)[2][2][4][2], const pg8::Unit& u, int wr, int wc, int fr, int fq) const {
        float ps[2][4], tot[2][4];
#pragma unroll
        for (int ai = 0; ai < 2; ++ai)
#pragma unroll
            for (int m = 0; m < 4; ++m) { float s = 0.f;
#pragma unroll
                for (int bj = 0; bj < 2; ++bj)
#pragma unroll
                    for (int n = 0; n < 2; ++n) { const f32x4 v = acc[ai][bj][m][n]; s += (v[0] * v[0] + v[1] * v[1]) + (v[2] * v[2] + v[3] * v[3]); }
                s += __shfl_xor(s, 16); s += __shfl_xor(s, 32); ps[ai][m] = s; }
        const int row0 = u.pm * 256 + wr * 64 + fr, col0 = u.pn * 256 + wc * 32 + 8 * fq;
        f32x4 gv[2][2], xpre[4][2];
#pragma unroll
        for (int bj = 0; bj < 2; ++bj) { gv[bj][0] = *(const f32x4*)(g + col0 + bj * 128); gv[bj][1] = *(const f32x4*)(g + col0 + bj * 128 + 4); }
#pragma unroll
        for (int m = 0; m < 4; ++m) { const float* xp = x + (size_t)(row0 + m * 16) * D_MODEL + col0; xpre[m][0] = *(const f32x4*)xp; xpre[m][1] = *(const f32x4*)(xp + 4); }
        panel_rowss_exchange(ps, tot, rss1, cnt1, u.pm, wr, wc, fr, fq, xl);
        float s2[2][4];
#pragma unroll
        for (int ai = 0; ai < 2; ++ai)
#pragma unroll
            for (int m = 0; m < 4; ++m) s2[ai][m] = 0.f;
#pragma unroll
        for (int ai = 0; ai < 2; ++ai)
#pragma unroll
            for (int bj = 0; bj < 2; ++bj) {
                f32x4 xa[4][2];
#pragma unroll
                for (int m = 0; m < 4; ++m) { if (ai == 0 && bj == 0) { xa[m][0] = xpre[m][0]; xa[m][1] = xpre[m][1]; }
                    else { const float* xp = x + (size_t)(row0 + ai * 128 + m * 16) * D_MODEL + col0 + bj * 128; xa[m][0] = *(const f32x4*)xp; xa[m][1] = *(const f32x4*)(xp + 4); } }
#pragma unroll
                for (int m = 0; m < 4; ++m) { const float rs = rsqrtf(tot[ai][m] * (1.f / D_MODEL) + EPS);
                    const f32x4 v0 = xa[m][0] + acc[ai][bj][m][0] * rs * gv[bj][0], v1 = xa[m][1] + acc[ai][bj][m][1] * rs * gv[bj][1];
                    s2[ai][m] += ((v0[0] * v0[0] + v0[1] * v0[1]) + (v0[2] * v0[2] + v0[3] * v0[3])) + ((v1[0] * v1[0] + v1[1] * v1[1]) + (v1[2] * v1[2] + v1[3] * v1[3]));
                    u32x4 w; w.x = pg8::cvt_pk_bf16(v0[0], v0[1]); w.y = pg8::cvt_pk_bf16(v0[2], v0[3]); w.z = pg8::cvt_pk_bf16(v1[0], v1[1]); w.w = pg8::cvt_pk_bf16(v1[2], v1[3]);
                    store16_wt(X1b + (size_t)(row0 + ai * 128 + m * 16) * D_MODEL + col0 + bj * 128, w); }
            }
#pragma unroll
        for (int ai = 0; ai < 2; ++ai)
#pragma unroll
            for (int m = 0; m < 4; ++m) { float s = s2[ai][m]; s += __shfl_xor(s, 16); s += __shfl_xor(s, 32); if (fq == 0) atomicAdd(rss2 + row0 + ai * 128 + m * 16, s); }
        handoff_signal(f3 + (u.pm * 2 + (u.pn >> 3)) * 16);
    }
};
struct EpiBf16 {
    bf16_t* O; size_t kstride; int ldc;
    __device__ __forceinline__ void operator()(const f32x4 (&acc)[2][2][4][2], const pg8::Unit& u, int wr, int wc, int fr, int fq) const {
        const int row0 = u.pm * 256 + wr * 64 + fr, col0 = u.pn * 256 + wc * 32 + 8 * fq;
        bf16_t* Ob = O + (size_t)u.kind * kstride;
#pragma unroll
        for (int ai = 0; ai < 2; ++ai)
#pragma unroll
            for (int m = 0; m < 4; ++m) { bf16_t* rowp = Ob + (size_t)(row0 + ai * 128 + m * 16) * ldc + col0;
#pragma unroll
                for (int bj = 0; bj < 2; ++bj) { const f32x4 v0 = acc[ai][bj][m][0], v1 = acc[ai][bj][m][1];
                    u32x4 w; w.x = pg8::cvt_pk_bf16(v0[0], v0[1]); w.y = pg8::cvt_pk_bf16(v0[2], v0[3]); w.z = pg8::cvt_pk_bf16(v1[0], v1[1]); w.w = pg8::cvt_pk_bf16(v1[2], v1[3]);
                    *(u32x4*)(rowp + bj * 128) = w; } }
    }
};

struct EpiBf16WT {
    bf16_t* O; size_t kstride; int ldc;
    __device__ __forceinline__ void operator()(const f32x4 (&acc)[2][2][4][2], const pg8::Unit& u, int wr, int wc, int fr, int fq) const {
        const int row0 = u.pm * 256 + wr * 64 + fr, col0 = u.pn * 256 + wc * 32 + 8 * fq;
        bf16_t* Ob = O + (size_t)u.kind * kstride;
#pragma unroll
        for (int ai = 0; ai < 2; ++ai)
#pragma unroll
            for (int m = 0; m < 4; ++m) { bf16_t* rowp = Ob + (size_t)(row0 + ai * 128 + m * 16) * ldc + col0;
#pragma unroll
                for (int bj = 0; bj < 2; ++bj) { const f32x4 v0 = acc[ai][bj][m][0], v1 = acc[ai][bj][m][1];
                    u32x4 w; w.x = pg8::cvt_pk_bf16(v0[0], v0[1]); w.y = pg8::cvt_pk_bf16(v0[2], v0[3]); w.z = pg8::cvt_pk_bf16(v1[0], v1[1]); w.w = pg8::cvt_pk_bf16(v1[2], v1[3]);
                    store16_wt(rowp + bj * 128, w); } }
    }
};

struct ProjSched {
    const bf16_t* H; const bf16_t* WinT; StaticOrder so;
    __device__ __forceinline__ bool next(int i, pg8::Unit& u) const {
        Order2 o; if (!so.next(i, o)) return false;
        const int sg_ = o.pn >> 3, seg = (sg_ == 0) ? 4 : (sg_ == 1) ? 0 : (sg_ == 2) ? 1 : (sg_ == 3) ? 5 : (sg_ == 4) ? 3 : 2, cp = o.pn & 7; o.pn = seg * 8 + cp;
        if (seg == 2) { u.A = (const char*)(WinT + (size_t)(COL_V + cp * 256) * D_MODEL); u.B = (const char*)(H + (size_t)o.pm * 256 * D_MODEL); u.pm = cp; u.pn = o.pm; u.kind = 2; u.perm = 2; }
        else { u.A = (const char*)(H + (size_t)o.pm * 256 * D_MODEL); u.B = (const char*)(WinT + (size_t)o.pn * 256 * D_MODEL); u.pm = o.pm; u.pn = cp; u.kind = seg; u.perm = 1; }
        return true;
    }
};
constexpr float QSCALE = 0.08838834764831845f * 1.4426950408889634f;
__device__ __forceinline__ float silu_fast(float x) { return x * __builtin_amdgcn_rcpf(1.f + __builtin_amdgcn_exp2f(-1.4426950408889634f * x)); }
__device__ __forceinline__ size_t kf_index(int b, int h, int kb, int st, int hh, int r) { return ((((size_t)(b * A_HEADS + h) * 64 + kb) * 8 + st) * 64 + hh * 32 + r) * 8; }
__device__ __forceinline__ size_t vf_index(int b, int h, int kb, int s, int db, int hh, int dl) { return (((((size_t)(b * A_HEADS + h) * 64 + kb) * 2 + s) * 4 + db) * 64 + hh * 32 + dl) * 8; }
struct EpiProj {
    bf16_t *Qs, *Kf, *Vf, *GA, *U, *GB;
    __device__ __forceinline__ void operator()(const f32x4 (&acc)[2][2][4][2], const pg8::Unit& u, int wr, int wc, int fr, int fq) const {
        bf16_t* base; int roff[2][4], coff[2];
        if (u.kind == 1) {
            base = Kf;
#pragma unroll
            for (int ai = 0; ai < 2; ++ai)
#pragma unroll
                for (int m = 0; m < 4; ++m) { const int tok = u.pm * 256 + ai * 128 + wr * 64 + m * 16 + fr; roff[ai][m] = ((tok >> 11) * A_HEADS * 64 + ((tok & 2047) >> 5)) * 4096 + (tok & 31) * 8; }
#pragma unroll
            for (int bj = 0; bj < 2; ++bj) coff[bj] = (2 * u.pn + bj) * 64 * 4096 + (2 * wc + (fq >> 1)) * 512 + (fq & 1) * 256;
        } else if (u.kind == 2) {
            base = Vf;
#pragma unroll
            for (int ai = 0; ai < 2; ++ai)
#pragma unroll
                for (int m = 0; m < 4; ++m) { const int vcol = u.pm * 256 + ai * 128 + wr * 64 + m * 16 + fr, d = vcol & 127; roff[ai][m] = (vcol >> 7) * 64 * 4096 + (d >> 5) * 512 + (d & 31) * 8; }
#pragma unroll
            for (int bj = 0; bj < 2; ++bj) { const int tok0 = u.pn * 256 + bj * 128 + wc * 32; coff[bj] = ((tok0 >> 11) * A_HEADS * 64 + ((tok0 & 2047) >> 5)) * 4096 + (fq >> 1) * 2048 + (fq & 1) * 256; }
        } else {
            base = u.kind == 0 ? Qs : (u.kind == 3 ? GA : (u.kind == 4 ? U : GB));
#pragma unroll
            for (int ai = 0; ai < 2; ++ai)
#pragma unroll
                for (int m = 0; m < 4; ++m) roff[ai][m] = (u.pm * 256 + ai * 128 + wr * 64 + m * 16 + fr) * A_WIDTH;
#pragma unroll
            for (int bj = 0; bj < 2; ++bj) coff[bj] = u.pn * 256 + wc * 32 + 8 * fq + bj * 128;
        }
        const bool act = (u.kind == 3) || (u.kind == 5); const float sc = (u.kind == 0) ? QSCALE : 1.f;
#pragma unroll
        for (int ai = 0; ai < 2; ++ai)
#pragma unroll
            for (int m = 0; m < 4; ++m)
#pragma unroll
                for (int bj = 0; bj < 2; ++bj) { f32x4 v0 = acc[ai][bj][m][0], v1 = acc[ai][bj][m][1];
                    if (act) {
#pragma unroll
                        for (int e = 0; e < 4; ++e) { v0[e] = silu_fast(v0[e]); v1[e] = silu_fast(v1[e]); } }
                    v0 = v0 * sc; v1 = v1 * sc;
                    u32x4 w; w.x = pg8::cvt_pk_bf16(v0[0], v0[1]); w.y = pg8::cvt_pk_bf16(v0[2], v0[3]); w.z = pg8::cvt_pk_bf16(v1[0], v1[1]); w.w = pg8::cvt_pk_bf16(v1[2], v1[3]);
                    *(u32x4*)(base + (size_t)(unsigned)(roff[ai][m] + coff[bj])) = w; }
    }
};

template <int W> __device__ __forceinline__ void pool_dtile_w(const bf16_t* up, bf16_t* dp, int tp0) {
    constexpr int NR = W - 1 + 8;
    const float iw = 1.f / (float)W;
#pragma unroll 1
    for (int c = 0; c < 4; ++c) {
        u32x4 r[NR];
        const int tpc = tp0 + 8 * c;
#pragma unroll
        for (int i = 0; i < NR; ++i) { int rel = 8 * c + i - (W - 1); rel = rel < -tp0 ? -tp0 : rel; r[i] = *(const u32x4*)(up + (ptrdiff_t)rel * B_WIDTH); }
#pragma unroll
        for (int i = 0; i < W - 1; ++i) { const bool ok = (tpc + i - (W - 1)) >= 0; r[i].x = ok ? r[i].x : 0u; r[i].y = ok ? r[i].y : 0u; r[i].z = ok ? r[i].z : 0u; r[i].w = ok ? r[i].w : 0u; }
        float sm[8];
#pragma unroll
        for (int e = 0; e < 8; ++e) sm[e] = 0.f;
#define POOL_ACC(raw_, sgn_) do { sm[0] += sgn_ bflo(raw_.x); sm[1] += sgn_ bfhi(raw_.x); sm[2] += sgn_ bflo(raw_.y); sm[3] += sgn_ bfhi(raw_.y); sm[4] += sgn_ bflo(raw_.z); sm[5] += sgn_ bfhi(raw_.z); sm[6] += sgn_ bflo(raw_.w); sm[7] += sgn_ bfhi(raw_.w); } while (0)
#pragma unroll
        for (int i = 0; i < W - 1; ++i) POOL_ACC(r[i], +);
#pragma unroll
        for (int k = 0; k < 8; ++k) {
            const u32x4 cur = r[W - 1 + k]; POOL_ACC(cur, +);
            if (k > 0) POOL_ACC(r[k - 1], -);
            const int tp = tpc + k; const float ic = (tp + 1 >= W) ? iw : 1.f / (float)(tp + 1);
            u32x4 o; o.x = pk2(sm[0] * ic - bflo(cur.x), sm[1] * ic - bfhi(cur.x)); o.y = pk2(sm[2] * ic - bflo(cur.y), sm[3] * ic - bfhi(cur.y));
            o.z = pk2(sm[4] * ic - bflo(cur.z), sm[5] * ic - bfhi(cur.z)); o.w = pk2(sm[6] * ic - bflo(cur.w), sm[7] * ic - bfhi(cur.w));
            *(u32x4*)(dp + (size_t)(8 * c + k) * B_GD) = o;
        }
#undef POOL_ACC
    }
}

struct Frame {
    LAS unsigned char* lds;
    int tid, lane, wave, G, gw, NGW;
};

__device__ __forceinline__ void p0_transpose_item(const float* W, int K, int N, bf16_t* WT, LAS float* scr, int item, int lane, const float* kscale = nullptr) {
    const int nblk = N / 32, kb = item / nblk, nb = item % nblk, k0 = 64 * kb, n0 = 32 * nb;
    f32x4 ld[8];
#pragma unroll
    for (int i = 0; i < 8; ++i) ld[i] = __builtin_nontemporal_load((const f32x4*)(W + (size_t)(k0 + 8 * i + (lane >> 3)) * N + n0 + 4 * (lane & 7)));
#pragma unroll
    for (int i = 0; i < 8; ++i) { LAS float* d = scr + (8 * i + (lane >> 3)) * 33 + 4 * (lane & 7); d[0] = ld[i][0]; d[1] = ld[i][1]; d[2] = ld[i][2]; d[3] = ld[i][3]; }
    LDS_WAIT(); asm volatile("" ::: "memory");
    const int c = lane & 7;
    f32x4 k0s = {1.f, 1.f, 1.f, 1.f}, k1s = {1.f, 1.f, 1.f, 1.f};
    if (kscale) { k0s = *(const f32x4*)(kscale + k0 + 8 * c); k1s = *(const f32x4*)(kscale + k0 + 8 * c + 4); }
#pragma unroll
    for (int j = 0; j < 4; ++j) { const int n = (lane >> 3) + 8 * j; const LAS float* s = scr + (8 * c) * 33 + n;
        u32x4 o; o.x = pk2(s[0 * 33] * k0s[0], s[1 * 33] * k0s[1]); o.y = pk2(s[2 * 33] * k0s[2], s[3 * 33] * k0s[3]); o.z = pk2(s[4 * 33] * k1s[0], s[5 * 33] * k1s[1]); o.w = pk2(s[6 * 33] * k1s[2], s[7 * 33] * k1s[3]);
        *(u32x4*)(WT + (size_t)(n0 + n) * K + k0 + 8 * c) = o; }
    LDS_WAIT(); asm volatile("" ::: "memory");
}
template <int NR> __device__ __forceinline__ void rms_rows_to_bf16(const float* const (&xrow)[NR], const LAS f32x4* g, bf16_t* const (&orow)[NR], int lane) {
    f32x4 v[NR][16];
#pragma unroll
    for (int r = 0; r < NR; ++r)
#pragma unroll
        for (int j = 0; j < 16; ++j) v[r][j] = __builtin_nontemporal_load((const f32x4*)xrow[r] + lane + 64 * j);
#pragma unroll
    for (int r = 0; r < NR; ++r) { float s = 0.f;
#pragma unroll
        for (int j = 0; j < 16; ++j) s += (v[r][j].x * v[r][j].x + v[r][j].y * v[r][j].y) + (v[r][j].z * v[r][j].z + v[r][j].w * v[r][j].w);
        const float rs = rsqrtf(wave_sum_f(s) * (1.f / D_MODEL) + EPS);
        unsigned long long* o8 = (unsigned long long*)orow[r] + lane;
#pragma unroll
        for (int j = 0; j < 16; ++j) { const f32x4 gg = g[lane + 64 * j];
            o8[64 * j] = (unsigned long long)pk2(v[r][j].x * rs * gg.x, v[r][j].y * rs * gg.y) | ((unsigned long long)pk2(v[r][j].z * rs * gg.z, v[r][j].w * rs * gg.w) << 32); } }
}

struct Args { const float* in[16]; float* out; unsigned char* ws; };

__global__ void __launch_bounds__(NWAVES * 64, 2) mk_fwd(Args args) {
    extern __shared__ __attribute__((aligned(16))) unsigned char lds_raw[];
    Frame F;
    F.lds = (LAS unsigned char*)lds_raw;
    F.tid = threadIdx.x; F.lane = F.tid & 63; F.wave = __builtin_amdgcn_readfirstlane(F.tid >> 6);
    F.G = gridDim.x; F.gw = (int)blockIdx.x * NWAVES + F.wave; F.NGW = F.G * NWAVES;
    volatile LAS unsigned* MISC = (volatile LAS unsigned*)(F.lds + MISC_OFF);
    unsigned char* ws = args.ws;
    for (int u = F.tid; u < (LDS_BYTES - LDSCTL_OFF) / 4; u += NWAVES * 64) ((LAS unsigned*)(F.lds + LDSCTL_OFF))[u] = 0u;
    __syncthreads();
    XcdBarrier bar = xcd_barrier_post((unsigned*)(ws + WS_CTL) + CW_BAR, MISC + 8);
#define GRID_BAR() xcd_barrier(bar)
#define PHASE_BEGIN(k) for (int rep_ = 0; rep_ <= ((PROBE_MASK >> (k)) & 1); ++rep_) {
#define PHASE_END() GRID_BAR(); }
#define PHASE_END_NOBAR() }

    const float* x = args.in[0]; const float* mem = args.in[1]; const float* g_mix_pre = args.in[2]; const float* w_in = args.in[3];
    const float* rel_bias = args.in[4]; const float* w_pool = args.in[5]; const float* pool_scale = args.in[6]; const float* w_out = args.in[7];
    const float* g_mix_post = args.in[8]; const float* g_xa_pre = args.in[9]; const float* g_mem = args.in[10]; const float* w_xq = args.in[11];
    const float* w_xk = args.in[12]; const float* w_xv = args.in[13]; const float* w_xo = args.in[14]; const float* g_xa_post = args.in[15];
    float* out = args.out;
    bf16_t* WinT = (bf16_t*)(ws + WS_WINT); bf16_t* WoutT = (bf16_t*)(ws + WS_WOUTT); bf16_t* WxqT = (bf16_t*)(ws + WS_WXQT); bf16_t* WxkT = (bf16_t*)(ws + WS_WXKT);
    bf16_t* WxvT = (bf16_t*)(ws + WS_WXVT); bf16_t* WxoT = (bf16_t*)(ws + WS_WXOT); bf16_t* WpT = (bf16_t*)(ws + WS_WPT);
    bf16_t* H = (bf16_t*)(ws + WS_H); bf16_t* Mn = (bf16_t*)(ws + WS_MN); bf16_t* YCAT = (bf16_t*)(ws + WS_YCAT);
    bf16_t* Qs = (bf16_t*)(ws + WS_QS); bf16_t* Kf = (bf16_t*)(ws + WS_KF); bf16_t* Vf = (bf16_t*)(ws + WS_VF); bf16_t* GA = (bf16_t*)(ws + WS_GA); bf16_t* U = (bf16_t*)(ws + WS_U); bf16_t* GB = (bf16_t*)(ws + WS_GB);
    bf16_t* X1b = (bf16_t*)(ws + WS_X1); bf16_t* Dscr = (bf16_t*)(ws + WS_DSCR);
    bf16_t* Qp = (bf16_t*)(ws + WS_QP); bf16_t* KXf = (bf16_t*)(ws + WS_KXF); bf16_t* VXf = (bf16_t*)(ws + WS_VXF); bf16_t* O = (bf16_t*)(ws + WS_O); bf16_t* XS = (bf16_t*)(ws + WS_XS);
    LAS float* scr = (LAS float*)(F.lds + RING_OFF + F.wave * 16384);

    PHASE_BEGIN(0)
    {
        const int lane = launder_i(F.lane);
        constexpr int I_IN = (D_MODEL / 64) * (IN_COLS / 32), I_OUT = (D_MODEL / 64) * (D_MODEL / 32), I_XQ = (D_MODEL / 64) * (XA_WIDTH / 32), I_XO = (XA_WIDTH / 64) * (D_MODEL / 32), I_P = (B_GD / 64) * (B_GD / 32);
        constexpr int NITEMS = I_IN + I_OUT + 3 * I_XQ + I_XO + 4 * I_P;
        for (int it = F.gw; it < NITEMS; it += F.NGW) {
            int r = it;
            if (r < I_IN) { p0_transpose_item(w_in, D_MODEL, IN_COLS, WinT, scr, r, lane); continue; } r -= I_IN;
            if (r < I_OUT) { p0_transpose_item(w_out, D_MODEL, D_MODEL, WoutT, scr, r, lane); continue; } r -= I_OUT;
            if (r < I_XQ) { p0_transpose_item(w_xq, D_MODEL, XA_WIDTH, WxqT, scr, r, lane, g_xa_pre); continue; } r -= I_XQ;
            if (r < I_XQ) { p0_transpose_item(w_xk, D_MODEL, XA_WIDTH, WxkT, scr, r, lane); continue; } r -= I_XQ;
            if (r < I_XQ) { p0_transpose_item(w_xv, D_MODEL, XA_WIDTH, WxvT, scr, r, lane); continue; } r -= I_XQ;
            if (r < I_XO) { p0_transpose_item(w_xo, XA_WIDTH, D_MODEL, WxoT, scr, r, lane); continue; } r -= I_XO;
            const int g = r / I_P; p0_transpose_item(w_pool + (size_t)g * B_GD * B_GD, B_GD, B_GD, WpT + (size_t)g * B_GD * B_GD, scr, r % I_P, lane);
        }
        __syncthreads();
        { LAS f32x4* gl = (LAS f32x4*)(F.lds + RING_OFF);
          for (int i = launder_i(F.tid); i < 2048; i += NWAVES * 64) gl[i] = (i < 1024) ? ((const f32x4*)g_mix_pre)[i] : ((const f32x4*)g_mem)[i - 1024]; }
        __syncthreads();
        { const LAS f32x4* gx = (const LAS f32x4*)(F.lds + RING_OFF); const LAS f32x4* gm = gx + 1024;
          for (int m = 2 * F.gw; m < NTOK; m += 2 * F.NGW) {
              const float* const xr[2] = {x + (size_t)m * D_MODEL, x + (size_t)(m + 1) * D_MODEL}; bf16_t* const orow[2] = {H + (size_t)m * D_MODEL, H + (size_t)(m + 1) * D_MODEL};
              rms_rows_to_bf16<2>(xr, gx, orow, lane); }
          for (int m = F.gw; m < NMTOK; m += F.NGW) { const float* const xr[1] = {mem + (size_t)m * D_MODEL}; bf16_t* const orow[1] = {Mn + (size_t)m * D_MODEL}; rms_rows_to_bf16<1>(xr, gm, orow, lane); } }
    }
    PHASE_END()

    PHASE_BEGIN(1)
    {
        ProjSched S; S.H = H; S.WinT = WinT; S.so.init(NTOK, IN_COLS, F.G, (int)blockIdx.x);
        EpiProj E; E.Qs = Qs; E.Kf = Kf; E.Vf = Vf; E.GA = GA; E.U = U; E.GB = GB;
        pg8::Geom g; g.K = D_MODEL; g.lda = D_MODEL; g.ldb = D_MODEL;
        pg8::gemm_phase(F.lds + RING_OFF, g, S, E);
    }
    PHASE_END()

    PHASE_BEGIN(2)
    {
        const int lane = launder_i(F.lane);
        for (int rep2_ = 0; rep2_ <= ((PROBE_MASK >> 11) & 1); ++rep2_)
        {
            const int w = F.wave, hh = w >> 2, ci = (w >> 1) & 1, qh = w & 1, r32 = lane & 31, hi = lane >> 5, kvsel = (w >> 1) & 1;
            LAS unsigned char* ring = F.lds + RING_OFF;
            LAS float* btab = (LAS float*)(F.lds + BIAS_OFF);
#define ATT_WAIT_V(n) asm volatile("s_waitcnt vmcnt(" #n ")" ::: "memory")
#define ATT_BAR() do { asm volatile("s_waitcnt lgkmcnt(0)" ::: "memory"); __builtin_amdgcn_s_barrier(); asm volatile("" ::: "memory"); } while (0)
            for (int ui = (int)blockIdx.x; ui < 512; ui += F.G) {
                const int hp = ui & 7, cp = (ui >> 3) & 15, b = ui >> 7;
                const int c0 = 2 * cp, h0 = 2 * hp, h = h0 + hh, c = c0 + ci;
                const int kc_lo = c0 >= 8 ? c0 - 8 : 0, nst = 2 * (c0 + 2 - kc_lo);
                for (int i = F.tid; i < 1536; i += NWAVES * 64) { const int e = i >= 768 ? 1 : 0, idx = 703 - (i - 768 * e); const float* rb = rel_bias + (h0 + e) * REL_SIZE;
                    btab[i] = (idx < 0 || idx >= 640) ? -3.0e38f : (rb[idx < 191 ? idx : 191] - rb[191]) * 1.4426950408889634f; }
                bf16x8 qf[8];
                { const int lq = launder_i(lane); const bf16_t* qp = Qs + ((size_t)b * SEQ + c * CHUNK + 32 * qh + (lq & 31)) * A_WIDTH + h * A_HD + 8 * (lq >> 5);
#pragma unroll
                  for (int st = 0; st < 8; ++st) qf[st] = *(const bf16x8*)(qp + 16 * st); }
                const bf16_t* src0 = (kvsel ? Vf : Kf) + ((size_t)(b * A_HEADS + h) * 64 + 2 * kc_lo) * 4096 + (4 * qh) * 512 + launder_i(lane) * 8;
                const unsigned dst0 = (unsigned)(hh * 16384 + kvsel * 8192 + (4 * qh) * 1024);
                const int nch = nst >> 1, rot = (c0 >= 8) ? (10 - kc_lo % 10) % 10 : 0;
#define ATT_VB(q_) (2 * ((((q_) >> 1) + rot) >= nch ? ((q_) >> 1) + rot - nch : ((q_) >> 1) + rot) + ((q_) & 1))
#define ATT_STAGE(s_) do { const bf16_t* sp_ = src0 + (size_t)ATT_VB(s_) * 4096; const unsigned d_ = (unsigned)(((s_) & 3) * 32768) + dst0; \
                    _Pragma("unroll") for (int i_ = 0; i_ < 4; ++i_) __builtin_amdgcn_global_load_lds((const unsigned*)(sp_ + i_ * 512), (LAS unsigned*)(ring + d_ + i_ * 1024), 16, 0, 0); } while (0)
                ATT_STAGE(0); ATT_STAGE(1); ATT_STAGE(2);
                const LAS float* bp0 = btab + hh * 768 + 703 - (32 * qh + r32 + 575 - 4 * hi - 64 * (kc_lo - c + 8));
                const int s_lo = (ci == 1 && c0 >= 8) ? 2 : 0, s_hi = (ci == 0) ? nst - 2 : nst;
                const LAS float* bpm = btab + hh * 768;
#define ATT_BP(q_) ((ATT_VB(q_) >= s_lo && ATT_VB(q_) < s_hi) ? bp0 + 32 * ATT_VB(q_) : bpm)
                float m_run = -1e30f, l_run = 0.f;
                f32x16 o[4];
#pragma unroll
                for (int db = 0; db < 4; ++db)
#pragma unroll
                    for (int r = 0; r < 16; ++r) o[db][r] = 0.f;
                f32x16 sA, sB;
#define ATT_MAX3(d_, a_, b_, c_) asm("v_max3_f32 %0, %1, %2, %3" : "=v"(d_) : "v"(a_), "v"(b_), "v"(c_))
#define ATT_CVT(d_, a_, b_) do { typedef __bf16 bf2_ __attribute__((ext_vector_type(2))); typedef float f2_ __attribute__((ext_vector_type(2))); f2_ t_; t_[0] = (a_); t_[1] = (b_); d_ = __builtin_bit_cast(unsigned, __builtin_convertvector(t_, bf2_)); } while (0)
#define ATT_QK_LOADS(q_, S_, BP_) const LAS bf16x8* kp_ = (const LAS bf16x8*)(ring + ((q_) & 3) * 32768 + hh * 16384) + lane; bf16x8 kf_[8]; \
                    _Pragma("unroll") for (int st = 0; st < 8; ++st) kf_[st] = kp_[st * 64]; \
                    { const LAS float* bp_ = (BP_); _Pragma("unroll") for (int r = 0; r < 16; ++r) S_[r] = bp_[(r & 3) + 8 * (r >> 2)]; }
#define ATT_PV_LOADS(p_) const LAS bf16x8* vp_ = (const LAS bf16x8*)(ring + ((p_) & 3) * 32768 + hh * 16384 + 8192) + lane; bf16x8 vf_[8]; \
                    _Pragma("unroll") for (int i = 0; i < 8; ++i) vf_[i] = vp_[i * 64];
#define ATT_QK_MFMA(S_) _Pragma("unroll") for (int st = 0; st < 8; ++st) S_ = __builtin_amdgcn_mfma_f32_32x32x16_bf16(kf_[st], qf[st], S_, 0, 0, 0);
#define ATT_SOFTMAX(S_) float ps0_ = 0.f; \
                    _Pragma("unroll") for (int r = 0; r < 16; ++r) { S_[r] = __builtin_amdgcn_exp2f(S_[r] - m_run); ps0_ += S_[r]; } \
                    bf16x8 pf_[2]; _Pragma("unroll") for (int s2 = 0; s2 < 2; ++s2) { u32x4 pw_; ATT_CVT(pw_.x, S_[8 * s2 + 0], S_[8 * s2 + 1]); ATT_CVT(pw_.y, S_[8 * s2 + 2], S_[8 * s2 + 3]); \
                        ATT_CVT(pw_.z, S_[8 * s2 + 4], S_[8 * s2 + 5]); ATT_CVT(pw_.w, S_[8 * s2 + 6], S_[8 * s2 + 7]); pf_[s2] = __builtin_bit_cast(bf16x8, pw_); }
#define ATT_PV_MFMA() _Pragma("unroll") for (int s2 = 0; s2 < 2; ++s2) _Pragma("unroll") for (int db = 0; db < 4; ++db) o[db] = __builtin_amdgcn_mfma_f32_32x32x16_bf16(vf_[s2 * 4 + db], pf_[s2], o[db], 0, 0, 0);
#define ATT_NEWMAX(S_) { float a_, b_, c_, d_, e_; ATT_MAX3(a_, S_[0], S_[1], S_[2]); ATT_MAX3(b_, S_[3], S_[4], S_[5]); ATT_MAX3(c_, S_[6], S_[7], S_[8]); ATT_MAX3(d_, S_[9], S_[10], S_[11]); \
                    ATT_MAX3(e_, S_[12], S_[13], S_[14]); ATT_MAX3(a_, a_, b_, c_); ATT_MAX3(d_, d_, e_, S_[15]); float mx_; ATT_MAX3(mx_, a_, d_, d_); \
                    { const auto sw_ = __builtin_amdgcn_permlane32_swap(__float_as_uint(mx_), __float_as_uint(mx_), false, false); float x0_ = __uint_as_float(sw_[0]), x1_ = __uint_as_float(sw_[1]); ATT_MAX3(mx_, x0_, x1_, x1_); } \
                    if (!__all(mx_ <= m_run + 8.f)) { const float mn_ = fmaxf(m_run, mx_), alpha_ = __builtin_amdgcn_exp2f(m_run - mn_); \
                        _Pragma("unroll") for (int db = 0; db < 4; ++db) _Pragma("unroll") for (int r = 0; r < 16; ++r) o[db][r] *= alpha_; \
                        l_run *= alpha_; m_run = mn_; } }
#define ATT_SYNC(q_) do { if ((q_) + 1 < nst) ATT_WAIT_V(4); else ATT_WAIT_V(0); ATT_BAR(); if ((q_) + 2 < nst) ATT_STAGE((q_) + 2); } while (0)
#define ATT_BOTH(q_, NXT_, CUR_, BP_) do { ATT_QK_LOADS(q_, NXT_, BP_) __builtin_amdgcn_sched_barrier(0); \
                        ATT_SOFTMAX(CUR_) ATT_QK_MFMA(NXT_) ATT_PV_LOADS((q_) - 1) \
                        __builtin_amdgcn_sched_group_barrier(0x008, 1, 0); __builtin_amdgcn_sched_group_barrier(0x402, 7, 0); \
                        _Pragma("unroll") for (int g_ = 0; g_ < 7; ++g_) { __builtin_amdgcn_sched_group_barrier(0x008, 1, 0); __builtin_amdgcn_sched_group_barrier(0x100, 1, 0); __builtin_amdgcn_sched_group_barrier(0x402, 7, 0); } \
                        __builtin_amdgcn_sched_group_barrier(0x100, 1, 0); \
                        __builtin_amdgcn_sched_barrier(0); ATT_PV_MFMA() l_run += ps0_; ATT_NEWMAX(NXT_) } while (0)
#define ATT_QKONLY(q_, NXT_) do { ATT_QK_LOADS(q_, NXT_, ATT_BP(q_)) __builtin_amdgcn_sched_barrier(0); ATT_QK_MFMA(NXT_) ATT_NEWMAX(NXT_) } while (0)
#define ATT_SMONLY(p_, CUR_) do { ATT_PV_LOADS(p_) __builtin_amdgcn_sched_barrier(0); ATT_SOFTMAX(CUR_) ATT_PV_MFMA() l_run += ps0_; } while (0)
                ATT_WAIT_V(8); ATT_BAR();
                ATT_QKONLY(0, sA);
#pragma unroll 1
                for (int q = 1; q < nst - 3; q += 2) {
                    ATT_SYNC(q); ATT_BOTH(q, sB, sA, ATT_BP(q));
                    ATT_SYNC(q + 1); ATT_BOTH(q + 1, sA, sB, ATT_BP(q + 1));
                }
                ATT_SYNC(nst - 3); ATT_BOTH(nst - 3, sB, sA, ATT_BP(nst - 3));
                ATT_SYNC(nst - 2); ATT_BOTH(nst - 2, sA, sB, ATT_BP(nst - 2));
                ATT_SYNC(nst - 1); ATT_BOTH(nst - 1, sB, sA, ATT_BP(nst - 1));
                ATT_SMONLY(nst - 1, sB);
#undef ATT_SYNC
#undef ATT_BP
#undef ATT_BOTH
#undef ATT_QKONLY
#undef ATT_SMONLY
#undef ATT_NEWMAX
#undef ATT_PV_MFMA
#undef ATT_SOFTMAX
#undef ATT_QK_MFMA
#undef ATT_PV_LOADS
#undef ATT_QK_LOADS
#undef ATT_CVT
#undef ATT_MAX3
                ATT_BAR();
                const float inv = 1.f / (l_run + __shfl_xor(l_run, 32));
                { LAS unsigned char* scw = ring + w * 16384 + r32 * 512;
#pragma unroll
                  for (int db = 0; db < 4; ++db)
#pragma unroll
                      for (int g4 = 0; g4 < 4; ++g4) { f32x4 v_; v_[0] = o[db][4 * g4 + 0] * inv; v_[1] = o[db][4 * g4 + 1] * inv; v_[2] = o[db][4 * g4 + 2] * inv; v_[3] = o[db][4 * g4 + 3] * inv;
                          *(LAS f32x4*)(scw + (((8 * db + 2 * g4 + hi) ^ r32) << 4)) = v_; } }
                { const int le = launder_i(lane), qr = le >> 4, k8 = le & 15;
                  const size_t orow = (size_t)b * SEQ + c * CHUNK + 32 * qh + qr;
                  const bf16_t* gap = GA + orow * A_WIDTH + h * A_HD + 8 * k8;
                  bf16_t* yp = YCAT + orow * D_MODEL + h * A_HD + 8 * k8;
                  u32x4 gr[8];
#pragma unroll
                  for (int i = 0; i < 8; ++i) gr[i] = *(const u32x4*)(gap + (size_t)(4 * i) * A_WIDTH);
                  const LAS unsigned char* scr_ = ring + w * 16384;
#pragma unroll
                  for (int i = 0; i < 8; ++i) { const int q_ = 4 * i + qr; const LAS unsigned char* rp_ = scr_ + q_ * 512 + (((2 * k8) ^ q_) << 4);
                      const f32x4 a0 = *(const LAS f32x4*)rp_, a1 = *(const LAS f32x4*)((const LAS unsigned char*)((unsigned)(size_t)rp_ ^ 16u));
                      u32x4 ov; ov.x = pg8::cvt_pk_bf16(a0[0] * bflo(gr[i].x), a0[1] * bfhi(gr[i].x)); ov.y = pg8::cvt_pk_bf16(a0[2] * bflo(gr[i].y), a0[3] * bfhi(gr[i].y));
                      ov.z = pg8::cvt_pk_bf16(a1[0] * bflo(gr[i].z), a1[1] * bfhi(gr[i].z)); ov.w = pg8::cvt_pk_bf16(a1[2] * bflo(gr[i].w), a1[3] * bfhi(gr[i].w));
                      *(u32x4*)(yp + (size_t)(4 * i) * D_MODEL) = ov; } }
                asm volatile("s_waitcnt vmcnt(0)" ::: "memory");
                ATT_BAR();
            }
#undef ATT_STAGE
#undef ATT_VB
#undef ATT_WAIT_V
#undef ATT_BAR
        }
    }
    for (int rep2_ = 0; rep2_ <= ((PROBE_MASK >> 12) & 1); ++rep2_)
    {
        const int L = (int)blockIdx.x;
        for (int rep3_ = 0; rep3_ <= ((PROBE_MASK >> 14) & 1); ++rep3_)
        if (L < 256) {
            const int tid = launder_i(F.tid), cg = tid & 63, sg = tid >> 6, g = L >> 6, pm = L & 31;
            const int row0 = pm * 256 + sg * 32, tp0 = row0 & (SEQ - 1);
            const bf16_t* up = U + (size_t)row0 * B_WIDTH + g * B_GD + cg * 8;
            bf16_t* dp = Dscr + ((size_t)L * 256 + sg * 32) * B_GD + cg * 8;
            if (g == 0) pool_dtile_w<2>(up, dp, tp0); else if (g == 1) pool_dtile_w<4>(up, dp, tp0); else if (g == 2) pool_dtile_w<8>(up, dp, tp0); else pool_dtile_w<16>(up, dp, tp0);
        }
        asm volatile("s_waitcnt vmcnt(0)" ::: "memory"); __syncthreads();
        PoolSched S; S.Dscr = Dscr; S.WpT = WpT; S.G = F.G; S.c = (int)blockIdx.x;
        EpiPool E; E.pool_scale = pool_scale; E.GB = GB; E.YCAT = YCAT;
        pg8::Geom g; g.K = B_GD; g.lda = B_GD; g.ldb = B_GD;
        for (int rep3_ = 0; rep3_ <= ((PROBE_MASK >> 15) & 1); ++rep3_)
        pg8::gemm_phase(F.lds + RING_OFF, g, S, E);
    }
    for (int rep2_ = 0; rep2_ <= ((PROBE_MASK >> 13) & 1); ++rep2_)
    {
        XkvSched S; S.Mn = Mn; S.WxkvT = WxkT; S.G = F.G; S.c = (int)blockIdx.x;
        XkvEpi E; E.XS = XS;
        pg8::Geom g; g.K = 512; g.lda = D_MODEL; g.ldb = D_MODEL;
        pg8::gemm_phase(F.lds + RING_OFF, g, S, E);
    }
    PHASE_END()

    PHASE_BEGIN(5)
    {
        const int tid = launder_i(F.tid);
        for (size_t i8 = (size_t)blockIdx.x * (NWAVES * 64) + tid; i8 < 2 * XF_ELEMS / 8; i8 += (size_t)F.G * (NWAVES * 64)) {
            const bf16_t* p = XS + i8 * 8;
            u32x4 t[8];
#pragma unroll
            for (int sl = 0; sl < 8; ++sl) t[sl] = *(const u32x4*)(p + (size_t)sl * 2 * XF_ELEMS);
            f32x4 a0 = {0.f, 0.f, 0.f, 0.f}, a1 = {0.f, 0.f, 0.f, 0.f};
#pragma unroll
            for (int sl = 0; sl < 8; ++sl) { a0.x += bflo(t[sl].x); a0.y += bfhi(t[sl].x); a0.z += bflo(t[sl].y); a0.w += bfhi(t[sl].y); a1.x += bflo(t[sl].z); a1.y += bfhi(t[sl].z); a1.z += bflo(t[sl].w); a1.w += bfhi(t[sl].w); }
            u32x4 o; o.x = pk2(a0.x, a0.y); o.y = pk2(a0.z, a0.w); o.z = pk2(a1.x, a1.y); o.w = pk2(a1.z, a1.w);
            store16_wt(KXf + i8 * 8, o);
        }
        handoff_signal((unsigned*)(ws + WS_CTL) + CW_FKV + ((int)blockIdx.x >> 4) * 16);
    }
    {
        PanelSched S; S.A = (const char*)YCAT; S.B = (const char*)WoutT; S.a_tile = (size_t)256 * D_MODEL * 2; S.b_tile = (size_t)256 * D_MODEL * 2; S.G = F.G; S.c = (int)blockIdx.x; S.perm = 1;
        EpiX1 E; E.x = x; E.g = g_mix_post; E.X1b = X1b; E.rss1 = (float*)(ws + WS_CTL) + CW_RSS1; E.cnt1 = (unsigned*)(ws + WS_CTL) + CW_CNT1; E.rss2 = (float*)(ws + WS_CTL) + CW_RSS2; E.xl = (LAS float*)(F.lds + XCH_OFF); E.f3 = (unsigned*)(ws + WS_CTL) + CW_F3;
        pg8::Geom g; g.K = D_MODEL; g.lda = D_MODEL; g.ldb = D_MODEL;
        pg8::gemm_phase(F.lds + RING_OFF, g, S, E);
    }
    PHASE_END_NOBAR()

    PHASE_BEGIN(7)
    {
        { const int L = (int)blockIdx.x, j = L >> 3; handoff_wait((unsigned*)(ws + WS_CTL) + CW_F3 + ((4 * (L & 7) + (j >> 3)) * 2 + (j & 1)) * 16, 8u, (unsigned*)(ws + WS_CTL) + CW_BAR); }
        QSplitSched S; S.H2 = X1b; S.WxqT = WxqT; S.G = F.G; S.c = (int)blockIdx.x;
        EpiBf16WT E; E.O = Qp; E.kstride = (size_t)NTOK * XA_WIDTH; E.ldc = XA_WIDTH;
        pg8::Geom g; g.K = 2048; g.lda = D_MODEL; g.ldb = D_MODEL;
        pg8::gemm_phase(F.lds + RING_OFF, g, S, E);
    }
    PHASE_END_NOBAR()
    {
        const int L = (int)blockIdx.x, x = L & 7, j = L >> 3, pm = 4 * x + (j >> 3), pn = (j >> 1) & 3;
        unsigned* f5 = (unsigned*)(ws + WS_CTL) + CW_F5 + (pm * 4 + pn) * 16;
        handoff_signal(f5);
        handoff_wait(f5, 2u, (unsigned*)(ws + WS_CTL) + CW_BAR);
        handoff_wait((unsigned*)(ws + WS_CTL) + CW_FKV + ((pm >> 3) * 4 + pn) * 16, 16u, (unsigned*)(ws + WS_CTL) + CW_BAR);
    }

    PHASE_BEGIN(8)
    {
        const int lane = launder_i(F.lane);
        const int ql = lane & 15, g = lane >> 4, w = F.wave;
        LAS unsigned char* ring = F.lds + RING_OFF;
#define XA_WAIT_V(n) asm volatile("s_waitcnt vmcnt(" #n ")" ::: "memory")
#define XA_BAR() do { asm volatile("s_waitcnt lgkmcnt(0)" ::: "memory"); __builtin_amdgcn_s_barrier(); asm volatile("" ::: "memory"); } while (0)
#define XA_STAGE(src_, half_) do { _Pragma("unroll") for (int i_ = 0; i_ < 8; ++i_) __builtin_amdgcn_global_load_lds((const unsigned*)((src_) + (size_t)(half_) * 32768 + i_ * 512), \
            (LAS unsigned*)(ring + (half_) * 65536 + w * 8192 + i_ * 1024), 16, 0, 0); } while (0)
        for (int ui = (int)blockIdx.x; ui < 256; ui += F.G) {
            const int pm6 = 4 * (ui & 7) + (ui >> 6), hd = (ui >> 4) & 3, qb = (pm6 & 7) * 2 + ((ui >> 3) & 1), b = pm6 >> 3;
            const size_t row = (size_t)b * SEQ + qb * 128 + w * 16 + ql;
            u32x4 qa[8], qb2[8];
            { const bf16_t* qp = Qp + row * XA_WIDTH + hd * XA_HD + 8 * g;
#pragma unroll
              for (int ks = 0; ks < 8; ++ks) { qa[ks] = *(const u32x4*)(qp + 32 * ks); qb2[ks] = *(const u32x4*)(qp + (size_t)NTOK * XA_WIDTH + 32 * ks); } }
            const bf16_t* ksrc = KXf + kxf_index(b, hd, 0, 0) + (size_t)(8 * w) * 512 + lane * 8;
            const bf16_t* vsrc = VXf + vxf_index(b, hd, 0, 0) + (size_t)(8 * w) * 512 + lane * 8;
            XA_STAGE(ksrc, 0); XA_STAGE(ksrc, 1);
            bf16x8 qf[8];
            { const float QS2 = 0.0625f * 1.4426950408889634f * rsqrtf(__hip_atomic_load((float*)(ws + WS_CTL) + CW_RSS2 + row, __ATOMIC_RELAXED, __HIP_MEMORY_SCOPE_AGENT) * (1.f / D_MODEL) + EPS);
#pragma unroll
              for (int ks = 0; ks < 8; ++ks) { const u32x4 a = qa[ks], c = qb2[ks];
                  u32x4 wq; wq.x = pg8::cvt_pk_bf16((bflo(a.x) + bflo(c.x)) * QS2, (bfhi(a.x) + bfhi(c.x)) * QS2); wq.y = pg8::cvt_pk_bf16((bflo(a.y) + bflo(c.y)) * QS2, (bfhi(a.y) + bfhi(c.y)) * QS2);
                  wq.z = pg8::cvt_pk_bf16((bflo(a.z) + bflo(c.z)) * QS2, (bfhi(a.z) + bfhi(c.z)) * QS2); wq.w = pg8::cvt_pk_bf16((bflo(a.w) + bflo(c.w)) * QS2, (bfhi(a.w) + bfhi(c.w)) * QS2);
                  qf[ks] = __builtin_bit_cast(bf16x8, wq); } }
            f32x4 st[16];
            const LAS bf16x8* lfp = (const LAS bf16x8*)ring + lane;
            XA_WAIT_V(8); XA_BAR();
#pragma unroll
            for (int kb = 0; kb < 8; ++kb) { f32x4 acc = {0.f, 0.f, 0.f, 0.f};
#pragma unroll
                for (int ks = 0; ks < 8; ++ks) acc = __builtin_amdgcn_mfma_f32_16x16x32_bf16(lfp[(kb * 8 + ks) * 64], qf[ks], acc, 0, 0, 0);
                st[kb] = acc; }
            XA_BAR();
            XA_STAGE(vsrc, 0);
            XA_WAIT_V(8); XA_BAR();
#pragma unroll
            for (int kb = 0; kb < 8; ++kb) { f32x4 acc = {0.f, 0.f, 0.f, 0.f};
#pragma unroll
                for (int ks = 0; ks < 8; ++ks) acc = __builtin_amdgcn_mfma_f32_16x16x32_bf16(lfp[4096 + (kb * 8 + ks) * 64], qf[ks], acc, 0, 0, 0);
                st[8 + kb] = acc; }
            XA_BAR();
            XA_STAGE(vsrc, 1);
            float mx = -3.0e38f;
#pragma unroll
            for (int kb = 0; kb < 16; ++kb) mx = fmaxf(fmaxf(mx, fmaxf(st[kb][0], st[kb][1])), fmaxf(st[kb][2], st[kb][3]));
            mx = fmaxf(mx, __shfl_xor(mx, 16)); mx = fmaxf(mx, __shfl_xor(mx, 32));
            float l = 0.f;
#pragma unroll
            for (int kb = 0; kb < 16; ++kb)
#pragma unroll
                for (int e = 0; e < 4; ++e) { st[kb][e] = __builtin_amdgcn_exp2f(st[kb][e] - mx); l += st[kb][e]; }
            l += __shfl_xor(l, 16); l += __shfl_xor(l, 32);
            const float inv = 1.f / l;
            f32x4 o[16];
#pragma unroll
            for (int db = 0; db < 16; ++db) o[db] = (f32x4){0.f, 0.f, 0.f, 0.f};
            XA_WAIT_V(8); XA_BAR();
#pragma unroll
            for (int kstep = 0; kstep < 4; ++kstep) {
                u32x4 pw; pw.x = pg8::cvt_pk_bf16(st[2 * kstep][0], st[2 * kstep][1]); pw.y = pg8::cvt_pk_bf16(st[2 * kstep][2], st[2 * kstep][3]);
                pw.z = pg8::cvt_pk_bf16(st[2 * kstep + 1][0], st[2 * kstep + 1][1]); pw.w = pg8::cvt_pk_bf16(st[2 * kstep + 1][2], st[2 * kstep + 1][3]);
                const bf16x8 pf = __builtin_bit_cast(bf16x8, pw);
#pragma unroll
                for (int db = 0; db < 16; ++db) o[db] = __builtin_amdgcn_mfma_f32_16x16x32_bf16(lfp[(kstep * 16 + db) * 64], pf, o[db], 0, 0, 0);
            }
            XA_WAIT_V(0); XA_BAR();
#pragma unroll
            for (int kstep = 4; kstep < 8; ++kstep) {
                u32x4 pw; pw.x = pg8::cvt_pk_bf16(st[2 * kstep][0], st[2 * kstep][1]); pw.y = pg8::cvt_pk_bf16(st[2 * kstep][2], st[2 * kstep][3]);
                pw.z = pg8::cvt_pk_bf16(st[2 * kstep + 1][0], st[2 * kstep + 1][1]); pw.w = pg8::cvt_pk_bf16(st[2 * kstep + 1][2], st[2 * kstep + 1][3]);
                const bf16x8 pf = __builtin_bit_cast(bf16x8, pw);
#pragma unroll
                for (int db = 0; db < 16; ++db) o[db] = __builtin_amdgcn_mfma_f32_16x16x32_bf16(lfp[4096 + ((kstep - 4) * 16 + db) * 64], pf, o[db], 0, 0, 0);
            }
            XA_BAR();
            { LAS unsigned char* sw_ = ring + w * 8192 + ql * 512 + (g & 1) * 8;
#pragma unroll
              for (int db = 0; db < 16; ++db)
                  *(LAS unsigned long long*)(sw_ + (((2 * db + (g >> 1)) ^ ql) << 4)) = (unsigned long long)pg8::cvt_pk_bf16(o[db][0] * inv, o[db][1] * inv) | ((unsigned long long)pg8::cvt_pk_bf16(o[db][2] * inv, o[db][3] * inv) << 32);
              const int le = launder_i(lane), rr = le >> 5, cc = le & 31;
              bf16_t* op = O + ((size_t)b * SEQ + qb * 128 + w * 16 + rr) * XA_WIDTH + hd * XA_HD + cc * 8;
#pragma unroll
              for (int i = 0; i < 8; ++i) { const int r_ = 2 * i + rr; const u32x4 v_ = *(const LAS u32x4*)(ring + w * 8192 + r_ * 512 + ((cc ^ r_) << 4)); store16_wt(op + (size_t)(2 * i) * XA_WIDTH, v_); } }
            asm volatile("s_waitcnt vmcnt(0)" ::: "memory");
        }
#undef XA_WAIT_V
#undef XA_BAR
#undef XA_STAGE
    }
    PHASE_END_NOBAR()
    {
        const int c = (int)blockIdx.x;
        unsigned* f6 = (unsigned*)(ws + WS_CTL) + CW_F6;
        handoff_signal(f6 + (4 * (c & 7) + (c >> 6)) * 16);
        const int pm0 = 4 * ((c & 7) >> 1) + (c >> 6);
        handoff_wait(f6 + pm0 * 16, 8u, (unsigned*)(ws + WS_CTL) + CW_BAR);
        handoff_wait(f6 + (16 + pm0) * 16, 8u, (unsigned*)(ws + WS_CTL) + CW_BAR);
    }

    PHASE_BEGIN(9)
    {
        PanelSched S; S.A = (const char*)O; S.B = (const char*)WxoT; S.a_tile = (size_t)256 * XA_WIDTH * 2; S.b_tile = (size_t)256 * XA_WIDTH * 2; S.G = F.G; S.c = (int)blockIdx.x; S.perm = 0;
        EpiOut E; E.out = out; E.X1b = X1b; E.g = g_xa_post; E.rss = (float*)(ws + WS_CTL) + CW_RSS3; E.cnt = (unsigned*)(ws + WS_CTL) + CW_CNT3; E.xl = (LAS float*)(F.lds + XCH_OFF);
        pg8::Geom g; g.K = XA_WIDTH; g.lda = XA_WIDTH; g.ldb = XA_WIDTH;
        pg8::gemm_phase(F.lds + RING_OFF, g, S, E);
    }
    PHASE_END_NOBAR()
}

extern "C" void kernel_launch(void* const* d_in, const int* in_sizes, int n_in, void* d_out, int out_size, void* d_ws, size_t ws_size, hipStream_t stream) {
    static int grid = 0;
    if (grid == 0) {
        if (n_in != 16 || in_sizes[0] != NTOK * D_MODEL || out_size != NTOK * D_MODEL || ws_size < WS_END) { fprintf(stderr, "kernel_launch: unexpected shapes (n_in %d, ws %zu)\n", n_in, ws_size); grid = -1; return; }
        int dev = 0, cus = 0, per_cu = 0;
        if (hipGetDevice(&dev) != hipSuccess || hipDeviceGetAttribute(&cus, hipDeviceAttributeMultiprocessorCount, dev) != hipSuccess) { grid = -1; return; }
        if (hipFuncSetAttribute((const void*)mk_fwd, hipFuncAttributeMaxDynamicSharedMemorySize, LDS_BYTES) != hipSuccess) { fprintf(stderr, "kernel_launch: hipFuncSetAttribute failed\n"); grid = -1; return; }
        if (hipOccupancyMaxActiveBlocksPerMultiprocessor(&per_cu, (const void*)mk_fwd, NWAVES * 64, LDS_BYTES) != hipSuccess || per_cu < 1) { fprintf(stderr, "kernel_launch: occupancy query says %d workgroups per CU\n", per_cu); (void)hipGetLastError(); grid = -1; return; }
        if (cus != 256) { fprintf(stderr, "kernel_launch: built for a 256-CU device (got %d CUs)\n", cus); grid = -1; return; }
        grid = cus;
    }
    if (grid < 0) return;
    if (hipMemsetAsync((char*)d_ws + WS_CTL, 0, CTL_ZERO_BYTES, stream) != hipSuccess) return;
    Args a{};
    for (int i = 0; i < 16; ++i) a.in[i] = (const float*)d_in[i];
    a.out = (float*)d_out; a.ws = (unsigned char*)d_ws;
    hipLaunchKernelGGL(mk_fwd, dim3(grid), dim3(NWAVES * 64), LDS_BYTES, stream, a);
}
```

```cpp
#include <hip/hip_runtime.h>
#include <cstdio>
#include <cstdint>
#define LAS __attribute__((address_space(3)))
typedef unsigned short bf16_t;
typedef short bf16x8 __attribute__((ext_vector_type(8)));
typedef float f32x4 __attribute__((ext_vector_type(4)));
typedef unsigned u32x4 __attribute__((ext_vector_type(4)));
typedef float f32x16 __attribute__((ext_vector_type(16)));
namespace pg8 {
constexpr int BM = 256, BK = 64, HALF = 128, HTB = HALF * BK * 2  , STAGE_BYTES = 8 * HTB;

__host__ __device__ __forceinline__ int lds_byte(int r, int c) { const int st = (r >> 4) * 2 + (c >> 5), rr = r & 15, cc = c & 31, ob = rr * 64 + cc * 2; return st * 1024 + (ob ^ (((ob >> 9) & 1) << 5)); }
__host__ __device__ __forceinline__ void stage_rc(int b, int& R, int& C) { const int st = b / 1024, sb = b % 1024, swz = sb ^ (((sb >> 9) & 1) << 5); R = (st >> 1) * 16 + swz / 64; C = (st & 1) * 32 + (swz % 64) / 2; }
__host__ __device__ __forceinline__ int perm_slot(int perm, int rho) {
    const int n = rho >> 4, i = rho & 15;
    if (perm == 1) return 8 * (i >> 2) + 4 * n + (i & 3);
    if (perm == 2) return 16 * (i >> 3) + 8 * n + 4 * ((i >> 2) & 1) + (i & 3);
    return rho;
}
struct Unit { const char* A; const char* B; int pm, pn, kind, perm; };
struct Geom { int K, lda, ldb; };

__device__ __forceinline__ unsigned cvt_pk_bf16(float lo, float hi) { unsigned r; asm volatile("v_cvt_pk_bf16_f32 %0, %1, %2" : "=v"(r) : "v"(lo), "v"(hi)); return r; }

template <class Epi, class Sched>
__device__ __forceinline__ void gemm_phase(LAS unsigned char* lds, const Geom g, const Sched& S, const Epi& E) {
    int tid_ = threadIdx.x; asm volatile("" : "+v"(tid_));
    const int tid = tid_, wid = __builtin_amdgcn_readfirstlane(tid >> 6), lane = tid & 63, wr = wid >> 2, wc = wid & 3, fr = lane & 15, fq = lane >> 4;
    const int K = g.K, nt = K / BK;
    int sR[2], sC[2];
#pragma unroll
    for (int i = 0; i < 2; ++i) stage_rc(tid * 16 + i * 8192, sR[i], sC[i]);
    unsigned voffA[2];
#pragma unroll
    for (int i = 0; i < 2; ++i) voffA[i] = (unsigned)(sR[i] * g.lda + sC[i]) * 2u;
#define PG8_SET_VOFFB(dst, prm) do { _Pragma("unroll") for (int _i = 0; _i < 2; ++_i) { const int _R = sR[_i]; const int _Rb = (_R & ~31) + perm_slot((prm), _R & 31); (dst)[_i] = (unsigned)(_Rb * g.ldb + sC[_i]) * 2u; } } while (0)
    const size_t kstep = (size_t)(BK * 2);
    const size_t hstepA = (size_t)HALF * g.lda * 2, hstepB = (size_t)HALF * g.ldb * 2;
    const unsigned ldsw = (unsigned)wid * 1024u;
    const int aoff = lds_byte(wr * 64 + fr, fq * 8), boff = lds_byte(wc * 32 + fr, fq * 8);
#define PG8_SA(b, h) (((b) * 2 + (h)) * HTB)
#define PG8_SB(b, h) ((4 + (b) * 2 + (h)) * HTB)
#define PG8_STAGE(bufoff, gbase, voff) do { _Pragma("unroll") for (int _i = 0; _i < 2; ++_i) \
        __builtin_amdgcn_global_load_lds((const unsigned*)((const char*)(gbase) + (voff)[_i]), (LAS unsigned*)(lds + (bufoff) + ldsw + _i * 8192), 16, 0, 0); } while (0)
#define PG8_LDA(dst, b, h) do { _Pragma("unroll") for (int m = 0; m < 4; ++m) _Pragma("unroll") for (int k = 0; k < 2; ++k) dst[m][k] = *(const LAS bf16x8*)(lds + PG8_SA(b, h) + aoff + m * 2048 + k * 1024); } while (0)
#define PG8_LDB(dst, b, h) do { _Pragma("unroll") for (int n = 0; n < 2; ++n) _Pragma("unroll") for (int k = 0; k < 2; ++k) dst[n][k] = *(const LAS bf16x8*)(lds + PG8_SB(b, h) + boff + n * 2048 + k * 1024); } while (0)
#define PG8_MMA(ai, bj, At, Bt) do { __builtin_amdgcn_s_setprio(1); _Pragma("unroll") for (int m = 0; m < 4; ++m) _Pragma("unroll") for (int n = 0; n < 2; ++n) _Pragma("unroll") for (int k = 0; k < 2; ++k) \
        acc[ai][bj][m][n] = __builtin_amdgcn_mfma_f32_16x16x32_bf16(Bt[n][k], At[m][k], acc[ai][bj][m][n], 0, 0, 0); __builtin_amdgcn_s_setprio(0); } while (0)
#define PG8_WAIT_V(n) asm volatile("s_waitcnt vmcnt(" #n ")" ::: "memory")
#define PG8_WAIT_L(n) asm volatile("s_waitcnt lgkmcnt(" #n ")" ::: "memory")
#define PG8_BAR __builtin_amdgcn_s_barrier()
#define PG8_SCHED __builtin_amdgcn_sched_barrier(0)
    Unit cur, nxt; int ui = 0;
    if (!S.next(0, cur)) return;
    f32x4 acc[2][2][4][2];
#pragma unroll
    for (int a = 0; a < 2; ++a)
#pragma unroll
        for (int b = 0; b < 2; ++b)
#pragma unroll
            for (int m = 0; m < 4; ++m)
#pragma unroll
                for (int n = 0; n < 2; ++n) acc[a][b][m][n] = (f32x4){0.f, 0.f, 0.f, 0.f};
    bf16x8 At[4][2], B0[2][2], B1[2][2];
    unsigned vBc[2], vBn[2];
    PG8_SET_VOFFB(vBc, cur.perm);
    const char* cA = cur.A; const char* cB = cur.B;
    PG8_STAGE(PG8_SB(0, 0), cB, vBc); PG8_STAGE(PG8_SB(0, 1), cB + hstepB, vBc); PG8_STAGE(PG8_SA(0, 0), cA, voffA); PG8_STAGE(PG8_SA(0, 1), cA + hstepA, voffA);
    if (wr == 1) PG8_BAR;
    PG8_WAIT_V(2); PG8_BAR;
    PG8_STAGE(PG8_SB(1, 0), cB + kstep, vBc); PG8_STAGE(PG8_SA(1, 0), cA + kstep, voffA); PG8_STAGE(PG8_SB(1, 1), cB + hstepB + kstep, vBc);
    PG8_WAIT_V(6); PG8_BAR;
    for (;;) {
        const bool has_next = S.next(ui + 1, nxt);
        const char* nA = has_next ? nxt.A : cA; const char* nB = has_next ? nxt.B : cB;
        if (has_next) { PG8_SET_VOFFB(vBn, nxt.perm); } else { vBn[0] = vBc[0]; vBn[1] = vBc[1]; }
        for (int t = 0; t < nt; t += 2) {
            const bool last = (t == nt - 2);
            const char* a1 = cA + (size_t)(t + 1) * kstep;
            const char* a2 = last ? nA : cA + (size_t)(t + 2) * kstep; const char* b2 = last ? nB : cB + (size_t)(t + 2) * kstep;
            const char* a3 = a2 + kstep; const char* b3 = b2 + kstep;
            unsigned vB2[2]; vB2[0] = last ? vBn[0] : vBc[0]; vB2[1] = last ? vBn[1] : vBc[1];
            PG8_LDB(B0, 0, 0); PG8_LDB(B1, 0, 1); PG8_SCHED; PG8_LDA(At, 0, 0); PG8_STAGE(PG8_SA(1, 1), a1 + hstepA, voffA);
            PG8_WAIT_V(8); PG8_WAIT_L(0); PG8_BAR; PG8_MMA(0, 0, At, B0); PG8_MMA(0, 1, At, B1); PG8_BAR; PG8_SCHED;
            PG8_LDA(At, 0, 1); PG8_STAGE(PG8_SB(0, 0), b2, vB2); PG8_STAGE(PG8_SB(0, 1), b2 + hstepB, vB2); PG8_STAGE(PG8_SA(0, 0), a2, voffA);
            PG8_WAIT_V(8); PG8_WAIT_L(0); PG8_BAR; PG8_MMA(1, 0, At, B0); PG8_MMA(1, 1, At, B1); PG8_BAR; PG8_SCHED;
            PG8_LDB(B0, 1, 0); PG8_LDB(B1, 1, 1); PG8_SCHED; PG8_LDA(At, 1, 0); PG8_STAGE(PG8_SA(0, 1), a2 + hstepA, voffA);
            PG8_WAIT_V(8); PG8_WAIT_L(0); PG8_BAR; PG8_MMA(0, 0, At, B0); PG8_MMA(0, 1, At, B1); PG8_BAR; PG8_SCHED;
            PG8_LDA(At, 1, 1); PG8_STAGE(PG8_SB(1, 0), b3, vB2); PG8_STAGE(PG8_SB(1, 1), b3 + hstepB, vB2); PG8_STAGE(PG8_SA(1, 0), a3, voffA);
            PG8_WAIT_V(8); PG8_WAIT_L(0); PG8_BAR; PG8_MMA(1, 0, At, B0); PG8_MMA(1, 1, At, B1); PG8_BAR; PG8_SCHED;
        }
        if (wr == 0) PG8_BAR;
        E(acc, cur, wr, wc, fr, fq);
        if (!has_next) break;
#pragma unroll
        for (int a = 0; a < 2; ++a)
#pragma unroll
            for (int b = 0; b < 2; ++b)
#pragma unroll
                for (int m = 0; m < 4; ++m)
#pragma unroll
                    for (int n = 0; n < 2; ++n) acc[a][b][m][n] = (f32x4){0.f, 0.f, 0.f, 0.f};
        cur = nxt; cA = nA; cB = nB; vBc[0] = vBn[0]; vBc[1] = vBn[1]; ++ui;
        if (wr == 1) PG8_BAR;
    }
    PG8_WAIT_V(0);
    PG8_BAR;
#undef PG8_SET_VOFFB
#undef PG8_SA
#undef PG8_SB
#undef PG8_STAGE
#undef PG8_LDA
#undef PG8_LDB
#undef PG8_MMA
#undef PG8_WAIT_V
#undef PG8_WAIT_L
#undef PG8_BAR
#undef PG8_SCHED
}
}

constexpr int D_MODEL = 4096, BATCH = 4, SEQ = 2048, NTOK = BATCH * SEQ;
constexpr int CHUNK = 64, NCHUNK = SEQ / CHUNK, A_WIDTH = 2048, A_HD = 128, A_HEADS = 16, REL_SIZE = 192;
constexpr int B_WIDTH = 2048, B_GROUPS = 4, B_GD = 512, IN_COLS = 12288;
constexpr int XA_HEADS = 4, XA_HD = 256, XA_WIDTH = 1024, N_MEM = 256, NMTOK = BATCH * N_MEM;
constexpr float EPS = 1e-6f;
constexpr int COL_Q = 0, COL_K = 2048, COL_V = 4096, COL_GA = 6144, COL_U = 8192, COL_GB = 10240;
constexpr int NWAVES = 8;
#ifndef PROBE_MASK
#define PROBE_MASK 0
#endif

constexpr size_t MiB = 1u << 20;
constexpr size_t WS_CTL = 0, CTL_ZERO_BYTES = 192 * 1024;
constexpr size_t WS_WINT = 2 * MiB, WS_WOUTT = 98 * MiB, WS_WXQT = 130 * MiB, WS_WXKT = 138 * MiB, WS_WXVT = 146 * MiB, WS_WXOT = 154 * MiB, WS_WPT = 162 * MiB;
constexpr size_t WS_H = 164 * MiB, WS_MN = 228 * MiB, WS_QS = 236 * MiB, WS_KF = 268 * MiB, WS_VF = 300 * MiB, WS_GA = 332 * MiB, WS_U = 364 * MiB, WS_GB = 396 * MiB, WS_YCAT = 428 * MiB, WS_Y = 492 * MiB, WS_X1 = 620 * MiB, WS_END = 748 * MiB;
constexpr size_t WS_DSCR = WS_Y;
constexpr size_t WS_QP = 528 * MiB, WS_KXF = 524 * MiB, WS_VXF = 526 * MiB, WS_O = 560 * MiB, WS_XS = WS_WINT;
constexpr int CW_BAR = 4096;
constexpr int CW_RSS1 = 8192, CW_RSS2 = 16384, CW_RSS3 = 24576;
constexpr int CW_CNT1 = 32768, CW_CNT3 = 36864;
constexpr size_t WS_RS0 = 256 * 1024;
constexpr int CW_FD = 45312;
constexpr int CW_FY = 44800, CW_FX = 47360;
constexpr int CW_F3 = 43520, CW_FKV = 44544;
constexpr int CW_F5 = 40960, CW_F6 = 43008;

constexpr int RING_OFF = 0, RING_BYTES = 131072;
constexpr int LDSCTL_OFF = RING_BYTES, MISC_OFF = LDSCTL_OFF + 320, BIAS_OFF = RING_BYTES + 2048, XCH_OFF = RING_BYTES + 8192;
constexpr int LDS_BYTES = 163840;

__device__ __forceinline__ float bflo(unsigned w) { return __uint_as_float(w << 16); }
__device__ __forceinline__ float bfhi(unsigned w) { return __uint_as_float(w & 0xffff0000u); }
__device__ __forceinline__ unsigned pk2(float lo, float hi) { unsigned r; asm volatile("v_cvt_pk_bf16_f32 %0, %1, %2" : "=v"(r) : "v"(lo), "v"(hi)); return r; }
__device__ __forceinline__ float wave_sum_f(float v) {
#pragma unroll
    for (int o = 32; o > 0; o >>= 1) v += __shfl_xor(v, o);
    return v;
}
#define LDS_WAIT() asm volatile("s_waitcnt lgkmcnt(0)" ::: "memory")
__device__ __forceinline__ void store16_wt(void* p, u32x4 v) { asm volatile("global_store_dwordx4 %0, %1, off sc1\n\ts_nop 1" :: "v"(p), "v"(v) : "memory"); }
__device__ __forceinline__ void store8_wt(void* p, unsigned long long v) { asm volatile("global_store_dwordx2 %0, %1, off sc1\n\ts_nop 1" :: "v"(p), "v"(v) : "memory"); }
__device__ __forceinline__ int launder_i(int v) { asm volatile("" : "+v"(v)); return v; }

#define XB_TMO      128
#define XB_XCNT(j)  (256  + 64 * (j))
#define XB_XSUB(j)  (1280 + 64 * (j))
#define XB_XGEN(j)  (2304 + 64 * (j))
#define XB_TOP      3328
#define XB_TOPGEN   3392
#define XCD_BAR_WORDS 3456
#define XB_SPIN_CAP (1u << 18)
__device__ __forceinline__ unsigned xb_ld(unsigned* p)              { return __hip_atomic_load(p, __ATOMIC_RELAXED, __HIP_MEMORY_SCOPE_AGENT); }
__device__ __forceinline__ unsigned xb_add(unsigned* p, unsigned v) { return __hip_atomic_fetch_add(p, v, __ATOMIC_RELAXED, __HIP_MEMORY_SCOPE_AGENT); }
__device__ __forceinline__ unsigned xb_xcc_id() { return (unsigned)__builtin_amdgcn_s_getreg((3 << 11) | 20) & 0xFu; }
#define XB_SPIN(cond, bar) do { unsigned _sp = 0; while (cond) { __builtin_amdgcn_s_sleep(1); \
    if ((++_sp & 255u) == 0u) { if (xb_ld(&(bar)[XB_TMO])) break; if (_sp > XB_SPIN_CAP) { atomicAdd(&(bar)[XB_TMO], 1u); break; } } } } while (0)
struct XcdBarrier { unsigned* bar; unsigned x; volatile LAS unsigned* st; };
__device__ __forceinline__ XcdBarrier xcd_barrier_post(unsigned* bar, volatile LAS unsigned* st) {
    XcdBarrier b; b.bar = bar; b.x = xb_xcc_id(); b.st = st;
    if (threadIdx.x == 0) (void)xb_add(&bar[XB_XCNT(b.x)], 1u);
    return b;
}
__device__ __forceinline__ void xcd_barrier_complete(unsigned* bar, unsigned x, unsigned& nloc, unsigned& nx) {
    const unsigned G = gridDim.x * gridDim.y * gridDim.z;
    unsigned sum, cnt, mine, sp = 0u;
    for (;;) {
        sum = 0u; cnt = 0u; mine = 0u;
#pragma unroll
        for (unsigned j = 0; j < 16; ++j) { const unsigned c = xb_ld(&bar[XB_XCNT(j)]); sum += c; cnt += (c > 0u) ? 1u : 0u; mine = (j == x) ? c : mine; }
        if (sum == G) break;
        __builtin_amdgcn_s_sleep(1);
        if ((++sp & 255u) == 0u) { if (xb_ld(&bar[XB_TMO])) break; if (sp > XB_SPIN_CAP) { atomicAdd(&bar[XB_TMO], 1u); break; } }
    }
    nloc = mine > 0u ? mine : 1u; nx = cnt > 0u ? cnt : 1u;
}
__device__ __forceinline__ void xcd_barrier(const XcdBarrier& b) {
    asm volatile("s_waitcnt vmcnt(0)" ::: "memory");
    __syncthreads();
    if (threadIdx.x == 0) {
        unsigned* bar = b.bar;
        __builtin_amdgcn_s_waitcnt(0);
        unsigned nloc = b.st[0], nx = b.st[1];
        if (nloc == 0u) { xcd_barrier_complete(bar, b.x, nloc, nx); b.st[0] = nloc; b.st[1] = nx; }
        const unsigned old = xb_add(&bar[XB_XSUB(b.x)], 1u);
        const unsigned gen = old / nloc;
        if (old + 1u == (gen + 1u) * nloc) {
            __builtin_amdgcn_fence(__ATOMIC_RELEASE, "agent");
            asm volatile("s_waitcnt vmcnt(0)" ::: "memory");
            const unsigned og = xb_add(&bar[XB_TOP], 1u);
            const unsigned tg = og / nx;
            if (og + 1u == (tg + 1u) * nx) xb_add(&bar[XB_TOPGEN], 1u);
            else XB_SPIN(xb_ld(&bar[XB_TOPGEN]) == tg, bar);
            __builtin_amdgcn_fence(__ATOMIC_ACQUIRE, "agent");
            xb_add(&bar[XB_XGEN(b.x)], 1u);
            asm volatile("s_waitcnt vmcnt(0)" ::: "memory");
        } else {
            XB_SPIN(xb_ld(&bar[XB_XGEN(b.x)]) == gen, bar);
            __builtin_amdgcn_fence(__ATOMIC_ACQUIRE, "agent");
            asm volatile("s_waitcnt vmcnt(0)" ::: "memory");
        }
    }
    __syncthreads();
}

__device__ __forceinline__ void handoff_signal(unsigned* f) {
    asm volatile("s_waitcnt vmcnt(0)" ::: "memory");
    __syncthreads();
    if (threadIdx.x == 0) (void)xb_add(f, 1u);
}
__device__ __forceinline__ void handoff_wait(unsigned* f, unsigned target, unsigned* bar) {
    if (threadIdx.x == 0) { XB_SPIN(xb_ld(f) < target, bar); __builtin_amdgcn_fence(__ATOMIC_ACQUIRE, "agent"); asm volatile("s_waitcnt vmcnt(0)" ::: "memory"); }
    __syncthreads();
}

__device__ __forceinline__ void handoff_wait2(unsigned* fa, unsigned ta, unsigned* fb, unsigned tb, unsigned* bar) {
    if (threadIdx.x == 0) { XB_SPIN(xb_ld(fa) < ta, bar); XB_SPIN(xb_ld(fb) < tb, bar); __builtin_amdgcn_fence(__ATOMIC_ACQUIRE, "agent"); asm volatile("s_waitcnt vmcnt(0)" ::: "memory"); }
    __syncthreads();
}

struct Order2 { int pm, pn; };
struct StaticOrder {
    int nM, nN, nwg, G, c;
    __device__ void init(int M, int N, int G_, int c_) { nM = M / 256; nN = N / 256; nwg = nM * nN; G = G_; c = c_; }
    __device__ bool next(int i, Order2& u) const {
        const long L = (long)i * G + c; if (L >= nwg) return false;
        int wgid = (int)L; { const int q = nwg / 8, r = nwg % 8, xcd = wgid % 8, off = wgid / 8; wgid = (xcd < r ? xcd * (q + 1) : r * (q + 1) + (xcd - r) * q) + off; }
        const int nig = 8 * nN, gid = wgid / nig, fm = gid * 8, gsz = (nM - fm) < 8 ? (nM - fm) : 8;
        u.pm = fm + ((wgid % nig) % gsz); u.pn = (wgid % nig) / gsz; return true;
    }
};
struct PanelSched {
    const char* A; const char* B; size_t a_tile, b_tile; int G, c, perm;
    __device__ __forceinline__ bool next(int i, pg8::Unit& u) const {
        if (i >= 2 || G != 256) return false;
        const int x = c & 7, j = c >> 3, pm = 16 * i + 4 * (x >> 1) + (j >> 3), pn = 8 * (x & 1) + (j & 7);
        u.A = A + (size_t)pm * a_tile; u.B = B + (size_t)pn * b_tile; u.pm = pm; u.pn = pn; u.kind = 0; u.perm = perm; return true;
    }
};
struct PoolSched {
    const bf16_t* Dscr; const bf16_t* WpT; int G, c;
    __device__ __forceinline__ bool next(int i, pg8::Unit& u) const {
        const int L = i * G + c; if (L >= 256) return false;
        const int g = L >> 6, pn = (L >> 5) & 1, pm = L & 31;
        u.A = (const char*)(Dscr + (size_t)(g * 32 + pm) * 256 * B_GD); u.B = (const char*)(WpT + ((size_t)g * B_GD + pn * 256) * B_GD);
        u.pm = pm; u.pn = pn; u.kind = g; u.perm = 1; return true;
    }
};
struct EpiPool {
    const float* pool_scale; const bf16_t* GB; bf16_t* YCAT;
    __device__ __forceinline__ void operator()(const f32x4 (&acc)[2][2][4][2], const pg8::Unit& u, int wr, int wc, int fr, int fq) const {
        const int row0 = u.pm * 256 + wr * 64 + fr, col0 = u.kind * B_GD + u.pn * 256 + wc * 32 + 8 * fq;
        f32x4 sc[2][2];
#pragma unroll
        for (int bj = 0; bj < 2; ++bj) { sc[bj][0] = *(const f32x4*)(pool_scale + col0 + bj * 128); sc[bj][1] = *(const f32x4*)(pool_scale + col0 + bj * 128 + 4); }
#pragma unroll
        for (int ai = 0; ai < 2; ++ai) {
            u32x4 grs[4][2];
#pragma unroll
            for (int m = 0; m < 4; ++m)
#pragma unroll
                for (int bj = 0; bj < 2; ++bj) grs[m][bj] = *(const u32x4*)(GB + (size_t)(row0 + ai * 128 + m * 16) * B_WIDTH + col0 + bj * 128);
#pragma unroll
            for (int m = 0; m < 4; ++m) { const size_t row = (size_t)(row0 + ai * 128 + m * 16);
#pragma unroll
                for (int bj = 0; bj < 2; ++bj) { const u32x4 gr = grs[m][bj];
                    const f32x4 v0 = acc[ai][bj][m][0] * sc[bj][0], v1 = acc[ai][bj][m][1] * sc[bj][1];
                    u32x4 w; w.x = pg8::cvt_pk_bf16(v0[0] * bflo(gr.x), v0[1] * bfhi(gr.x)); w.y = pg8::cvt_pk_bf16(v0[2] * bflo(gr.y), v0[3] * bfhi(gr.y));
                    w.z = pg8::cvt_pk_bf16(v1[0] * bflo(gr.z), v1[1] * bfhi(gr.z)); w.w = pg8::cvt_pk_bf16(v1[2] * bflo(gr.w), v1[3] * bfhi(gr.w));
                    store16_wt(YCAT + row * D_MODEL + A_WIDTH + col0 + bj * 128, w); } } }
    }
};
struct XkvSched {
    const bf16_t* Mn; const bf16_t* WxkvT; int G, c;
    __device__ __forceinline__ bool next(int i, pg8::Unit& u) const {
        const int L = i * G + c; if (L >= 256) return false;
        const int ks = L & 7, pn = (L >> 3) & 7, pm = L >> 6;
        const char* mrows = (const char*)(Mn + (size_t)pm * 256 * D_MODEL + ks * 512); const char* wrows = (const char*)(WxkvT + (size_t)pn * 256 * D_MODEL + ks * 512);
        if (pn < 4) { u.A = mrows; u.B = wrows; u.perm = 1; } else { u.A = wrows; u.B = mrows; u.perm = 0; }
        u.pm = pm; u.pn = pn; u.kind = ks; return true;
    }
};
__device__ __forceinline__ size_t kxf_index(int b, int hd, int kb16, int ks) { return ((((size_t)(b * XA_HEADS + hd) * 16 + kb16) * 8 + ks) * 64) * 8; }
__device__ __forceinline__ size_t vxf_index(int b, int hd, int kstep, int db) { return ((((size_t)(b * XA_HEADS + hd) * 8 + kstep) * 16 + db) * 64) * 8; }
constexpr size_t XF_ELEMS = (size_t)BATCH * XA_HEADS * 16 * 8 * 64 * 8;
struct XkvEpi {
    bf16_t* XS;
    __device__ __forceinline__ void operator()(const f32x4 (&acc)[2][2][4][2], const pg8::Unit& u, int wr, int wc, int fr, int fq) const {
        bf16_t* slab = XS + (size_t)u.kind * (2 * XF_ELEMS);
        if (u.pn < 4) {
#pragma unroll
            for (int ai = 0; ai < 2; ++ai)
#pragma unroll
                for (int m = 0; m < 4; ++m) { const int tok = u.pm * 256 + ai * 128 + wr * 64 + m * 16 + fr, b = tok >> 8, key = tok & 255;
#pragma unroll
                    for (int bj = 0; bj < 2; ++bj) { const int dcol = bj * 128 + wc * 32;
                        bf16_t* p = slab + kxf_index(b, u.pn, key >> 4, dcol >> 5) + ((key & 15) + 16 * fq) * 8;
                        const f32x4 v0 = acc[ai][bj][m][0], v1 = acc[ai][bj][m][1];
                        u32x4 w; w.x = pg8::cvt_pk_bf16(v0[0], v0[1]); w.y = pg8::cvt_pk_bf16(v0[2], v0[3]); w.z = pg8::cvt_pk_bf16(v1[0], v1[1]); w.w = pg8::cvt_pk_bf16(v1[2], v1[3]);
                        store16_wt(p, w); } }
        } else {
#pragma unroll
            for (int ai = 0; ai < 2; ++ai)
#pragma unroll
                for (int m = 0; m < 4; ++m) { const int d = ai * 128 + wr * 64 + m * 16 + fr;
#pragma unroll
                    for (int bj = 0; bj < 2; ++bj) { const int tok0 = u.pm * 256 + bj * 128 + wc * 32, b = tok0 >> 8, kstep = (tok0 & 255) >> 5;
                        bf16_t* p = slab + XF_ELEMS + vxf_index(b, u.pn - 4, kstep, d >> 4) + ((d & 15) + 16 * fq) * 8;
                        const f32x4 v0 = acc[ai][bj][m][0], v1 = acc[ai][bj][m][1];
                        u32x4 w; w.x = pg8::cvt_pk_bf16(v0[0], v0[1]); w.y = pg8::cvt_pk_bf16(v0[2], v0[3]); w.z = pg8::cvt_pk_bf16(v1[0], v1[1]); w.w = pg8::cvt_pk_bf16(v1[2], v1[3]);
                        store16_wt(p, w); } }
        }
    }
};
struct QSplitSched {
    const bf16_t* H2; const bf16_t* WxqT; int G, c;
    __device__ __forceinline__ bool next(int i, pg8::Unit& u) const {
        const int L = i * G + c; if (L >= 256) return false;
        const int x = L & 7, j = L >> 3, pm = 4 * x + (j >> 3), pn = (j >> 1) & 3, ks = j & 1;
        u.A = (const char*)(H2 + (size_t)pm * 256 * D_MODEL + ks * 2048); u.B = (const char*)(WxqT + (size_t)pn * 256 * D_MODEL + ks * 2048);
        u.pm = pm; u.pn = pn; u.kind = ks; u.perm = 1; return true;
    }
};
__device__ __forceinline__ void panel_rowss_exchange(const float (&ps)[2][4], float (&tot)[2][4], float* rss, unsigned* cnt, int pm, int wr, int wc, int fr, int fq, LAS float* xl) {
    LAS float* P = xl; LAS float* T = xl + 1024;
    const int wid = wr * 4 + wc, lane = fq * 16 + fr, tid = wid * 64 + lane, rloc = wr * 64 + fr;
    if (fq == 0) {
#pragma unroll
        for (int ai = 0; ai < 2; ++ai)
#pragma unroll
            for (int m = 0; m < 4; ++m) P[wc * 256 + rloc + ai * 128 + m * 16] = ps[ai][m];
    }
    asm volatile("s_waitcnt lgkmcnt(0)" ::: "memory"); __builtin_amdgcn_s_barrier(); asm volatile("" ::: "memory");
    if (tid < 256) atomicAdd(rss + pm * 256 + tid, (P[tid] + P[256 + tid]) + (P[512 + tid] + P[768 + tid]));
    asm volatile("s_waitcnt vmcnt(0) lgkmcnt(0)" ::: "memory"); __builtin_amdgcn_s_barrier(); asm volatile("" ::: "memory");
    if (wid == 0) {
        unsigned* c = cnt + 64 * pm;
        if (lane == 0) __hip_atomic_fetch_add(c, 1u, __ATOMIC_RELAXED, __HIP_MEMORY_SCOPE_AGENT);
        for (unsigned spin = 0; spin < (1u << 22); ++spin) {
            if ((unsigned)__builtin_amdgcn_readfirstlane(__hip_atomic_load(c, __ATOMIC_RELAXED, __HIP_MEMORY_SCOPE_AGENT)) >= 16u) break;
            __builtin_amdgcn_s_sleep(2);
        }
#pragma unroll
        for (int i = 0; i < 4; ++i) T[lane + 64 * i] = __hip_atomic_load(rss + pm * 256 + lane + 64 * i, __ATOMIC_RELAXED, __HIP_MEMORY_SCOPE_AGENT);
    }
    asm volatile("s_waitcnt vmcnt(0) lgkmcnt(0)" ::: "memory"); __builtin_amdgcn_s_barrier(); asm volatile("" ::: "memory");
#pragma unroll
    for (int ai = 0; ai < 2; ++ai)
#pragma unroll
        for (int m = 0; m < 4; ++m) tot[ai][m] = T[rloc + ai * 128 + m * 16];
}
struct EpiOut {
    float* out; const bf16_t* X1b; const float* g; float* rss; unsigned* cnt; LAS float* xl;
    __device__ __forceinline__ void operator()(const f32x4 (&acc)[2][2][4][2], const pg8::Unit& u, int wr, int wc, int fr, int fq) const {
        float ps[2][4], tot[2][4];
#pragma unroll
        for (int ai = 0; ai < 2; ++ai)
#pragma unroll
            for (int m = 0; m < 4; ++m) { float s = 0.f;
#pragma unroll
                for (int bj = 0; bj < 2; ++bj)
#pragma unroll
                    for (int n = 0; n < 2; ++n) { const f32x4 v = acc[ai][bj][m][n]; s += (v[0] * v[0] + v[1] * v[1]) + (v[2] * v[2] + v[3] * v[3]); }
                s += __shfl_xor(s, 16); s += __shfl_xor(s, 32); ps[ai][m] = s; }
        const int row0 = u.pm * 256 + wr * 64 + fr, col0 = u.pn * 256 + wc * 32 + 4 * fq;
        f32x4 gv[2][2]; unsigned long long xpre[4][2][2];
#pragma unroll
        for (int bj = 0; bj < 2; ++bj)
#pragma unroll
            for (int n = 0; n < 2; ++n) gv[bj][n] = *(const f32x4*)(g + col0 + bj * 128 + n * 16);
#pragma unroll
        for (int m = 0; m < 4; ++m)
#pragma unroll
            for (int bj = 0; bj < 2; ++bj)
#pragma unroll
                for (int n = 0; n < 2; ++n) xpre[m][bj][n] = *(const unsigned long long*)(X1b + (size_t)(row0 + m * 16) * D_MODEL + col0 + bj * 128 + n * 16);
        panel_rowss_exchange(ps, tot, rss, cnt, u.pm, wr, wc, fr, fq, xl);
#pragma unroll
        for (int ai = 0; ai < 2; ++ai) {
            unsigned long long xr[4][2][2];
#pragma unroll
            for (int m = 0; m < 4; ++m)
#pragma unroll
                for (int bj = 0; bj < 2; ++bj)
#pragma unroll
                    for (int n = 0; n < 2; ++n) xr[m][bj][n] = (ai == 0) ? xpre[m][bj][n] : *(const unsigned long long*)(X1b + (size_t)(row0 + ai * 128 + m * 16) * D_MODEL + col0 + bj * 128 + n * 16);
#pragma unroll
            for (int m = 0; m < 4; ++m) { const float rs = rsqrtf(tot[ai][m] * (1.f / D_MODEL) + EPS); float* rowp = out + (size_t)(row0 + ai * 128 + m * 16) * D_MODEL + col0;
#pragma unroll
                for (int bj = 0; bj < 2; ++bj)
#pragma unroll
                    for (int n = 0; n < 2; ++n) { const unsigned lo = (unsigned)xr[m][bj][n], hi = (unsigned)(xr[m][bj][n] >> 32); const f32x4 a = acc[ai][bj][m][n], gg = gv[bj][n];
                        f32x4 o; o[0] = bflo(lo) + a[0] * rs * gg[0]; o[1] = bfhi(lo) + a[1] * rs * gg[1]; o[2] = bflo(hi) + a[2] * rs * gg[2]; o[3] = bfhi(hi) + a[3] * rs * gg[3];
                        *(f32x4*)(rowp + bj * 128 + n * 16) = o; } }
        }
    }
};
struct EpiX1 {
    const bf16_t* xb; const float* g; bf16_t* X1b; float* rss1; unsigned* cnt1; float* rss2; LAS float* xl; unsigned* f3;
    __device__ __forceinline__ void operator()(const f32x4 (&acc)[2][2][4][2], const pg8::Unit& u, int wr, int wc, int fr, int fq) const {
        float ps[2][4], tot[2][4];
#pragma unroll
        for (int ai = 0; ai < 2; ++ai)
#pragma unroll
            for (int m = 0; m < 4; ++m) { float s = 0.f;
#pragma unroll
                for (int bj = 0; bj < 2; ++bj)
#pragma unroll
                    for (int n = 0; n < 2; ++n) { const f32x4 v = acc[ai][bj][m][n]; s += (v[0] * v[0] + v[1] * v[1]) + (v[2] * v[2] + v[3] * v[3]); }
                s += __shfl_xor(s, 16); s += __shfl_xor(s, 32); ps[ai][m] = s; }
        const int row0 = u.pm * 256 + wr * 64 + fr, col0 = u.pn * 256 + wc * 32 + 8 * fq;
        f32x4 gv[2][2]; u32x4 xpre[2][4];
#pragma unroll
        for (int bj = 0; bj < 2; ++bj) { gv[bj][0] = *(const f32x4*)(g + col0 + bj * 128); gv[bj][1] = *(const f32x4*)(g + col0 + bj * 128 + 4); }
#pragma unroll
        for (int bj = 0; bj < 2; ++bj)
#pragma unroll
            for (int m = 0; m < 4; ++m) xpre[bj][m] = *(const u32x4*)(xb + (size_t)(row0 + m * 16) * D_MODEL + col0 + bj * 128);
        panel_rowss_exchange(ps, tot, rss1, cnt1, u.pm, wr, wc, fr, fq, xl);
        if (u.pm >= 16 && threadIdx.x == 0) (void)xb_add(f3 + ((u.pm - 16) * 2 + (u.pn >> 3)) * 16, 1u);
        float s2[2][4];
#pragma unroll
        for (int ai = 0; ai < 2; ++ai)
#pragma unroll
            for (int m = 0; m < 4; ++m) s2[ai][m] = 0.f;
#pragma unroll
        for (int ai = 0; ai < 2; ++ai) {
            u32x4 xh[2][4];
#pragma unroll
            for (int bj = 0; bj < 2; ++bj)
#pragma unroll
                for (int m = 0; m < 4; ++m) xh[bj][m] = (ai == 0) ? xpre[bj][m] : *(const u32x4*)(xb + (size_t)(row0 + 128 + m * 16) * D_MODEL + col0 + bj * 128);
#pragma unroll
            for (int bj = 0; bj < 2; ++bj)
#pragma unroll
                for (int m = 0; m < 4; ++m) { const float rs = rsqrtf(tot[ai][m] * (1.f / D_MODEL) + EPS); const u32x4 xr = xh[bj][m];
                    const f32x4 xa0 = {bflo(xr.x), bfhi(xr.x), bflo(xr.y), bfhi(xr.y)}, xa1 = {bflo(xr.z), bfhi(xr.z), bflo(xr.w), bfhi(xr.w)};
                    const f32x4 v0 = xa0 + acc[ai][bj][m][0] * rs * gv[bj][0], v1 = xa1 + acc[ai][bj][m][1] * rs * gv[bj][1];
                    s2[ai][m] += ((v0[0] * v0[0] + v0[1] * v0[1]) + (v0[2] * v0[2] + v0[3] * v0[3])) + ((v1[0] * v1[0] + v1[1] * v1[1]) + (v1[2] * v1[2] + v1[3] * v1[3]));
                    u32x4 w; w.x = pg8::cvt_pk_bf16(v0[0], v0[1]); w.y = pg8::cvt_pk_bf16(v0[2], v0[3]); w.z = pg8::cvt_pk_bf16(v1[0], v1[1]); w.w = pg8::cvt_pk_bf16(v1[2], v1[3]);
                    store16_wt(X1b + (size_t)(row0 + ai * 128 + m * 16) * D_MODEL + col0 + bj * 128, w); }
        }
#pragma unroll
        for (int ai = 0; ai < 2; ++ai)
#pragma unroll
            for (int m = 0; m < 4; ++m) { float s = s2[ai][m]; s += __shfl_xor(s, 16); s += __shfl_xor(s, 32); if (fq == 0) atomicAdd(rss2 + row0 + ai * 128 + m * 16, s); }
        if (u.pm >= 16) handoff_signal(f3 + (u.pm * 2 + (u.pn >> 3)) * 16);
    }
};
struct EpiBf16 {
    bf16_t* O; size_t kstride; int ldc;
    __device__ __forceinline__ void operator()(const f32x4 (&acc)[2][2][4][2], const pg8::Unit& u, int wr, int wc, int fr, int fq) const {
        const int row0 = u.pm * 256 + wr * 64 + fr, col0 = u.pn * 256 + wc * 32 + 8 * fq;
        bf16_t* Ob = O + (size_t)u.kind * kstride;
#pragma unroll
        for (int ai = 0; ai < 2; ++ai)
#pragma unroll
            for (int m = 0; m < 4; ++m) { bf16_t* rowp = Ob + (size_t)(row0 + ai * 128 + m * 16) * ldc + col0;
#pragma unroll
                for (int bj = 0; bj < 2; ++bj) { const f32x4 v0 = acc[ai][bj][m][0], v1 = acc[ai][bj][m][1];
                    u32x4 w; w.x = pg8::cvt_pk_bf16(v0[0], v0[1]); w.y = pg8::cvt_pk_bf16(v0[2], v0[3]); w.z = pg8::cvt_pk_bf16(v1[0], v1[1]); w.w = pg8::cvt_pk_bf16(v1[2], v1[3]);
                    *(u32x4*)(rowp + bj * 128) = w; } }
    }
};

struct EpiBf16WT {
    bf16_t* O; size_t kstride; int ldc;
    __device__ __forceinline__ void operator()(const f32x4 (&acc)[2][2][4][2], const pg8::Unit& u, int wr, int wc, int fr, int fq) const {
        const int row0 = u.pm * 256 + wr * 64 + fr, col0 = u.pn * 256 + wc * 32 + 8 * fq;
        bf16_t* Ob = O + (size_t)u.kind * kstride;
#pragma unroll
        for (int ai = 0; ai < 2; ++ai)
#pragma unroll
            for (int m = 0; m < 4; ++m) { bf16_t* rowp = Ob + (size_t)(row0 + ai * 128 + m * 16) * ldc + col0;
#pragma unroll
                for (int bj = 0; bj < 2; ++bj) { const f32x4 v0 = acc[ai][bj][m][0], v1 = acc[ai][bj][m][1];
                    u32x4 w; w.x = pg8::cvt_pk_bf16(v0[0], v0[1]); w.y = pg8::cvt_pk_bf16(v0[2], v0[3]); w.z = pg8::cvt_pk_bf16(v1[0], v1[1]); w.w = pg8::cvt_pk_bf16(v1[2], v1[3]);
                    store16_wt(rowp + bj * 128, w); } }
    }
};

struct ProjSched {
    const bf16_t* H; const bf16_t* WinT; StaticOrder so;
    __device__ __forceinline__ bool next(int i, pg8::Unit& u) const {
        Order2 o; if (!so.next(i, o)) return false;
        const int sg_ = o.pn >> 3, seg = (sg_ == 0) ? 4 : (sg_ == 1) ? 0 : (sg_ == 2) ? 1 : (sg_ == 3) ? 5 : (sg_ == 4) ? 3 : 2, cp = o.pn & 7; o.pn = seg * 8 + cp;
        if (seg == 2) { u.A = (const char*)(WinT + (size_t)(COL_V + cp * 256) * D_MODEL); u.B = (const char*)(H + (size_t)o.pm * 256 * D_MODEL); u.pm = cp; u.pn = o.pm; u.kind = 2; u.perm = 2; }
        else { u.A = (const char*)(H + (size_t)o.pm * 256 * D_MODEL); u.B = (const char*)(WinT + (size_t)o.pn * 256 * D_MODEL); u.pm = o.pm; u.pn = cp; u.kind = seg; u.perm = 1; }
        return true;
    }
};
constexpr float QSCALE = 0.08838834764831845f * 1.4426950408889634f;
__device__ __forceinline__ float silu_fast(float x) { return x * __builtin_amdgcn_rcpf(1.f + __builtin_amdgcn_exp2f(-1.4426950408889634f * x)); }
__device__ __forceinline__ size_t kf_index(int b, int h, int kb, int st, int hh, int r) { return ((((size_t)(b * A_HEADS + h) * 64 + kb) * 8 + st) * 64 + hh * 32 + r) * 8; }
__device__ __forceinline__ size_t vf_index(int b, int h, int kb, int s, int db, int hh, int dl) { return (((((size_t)(b * A_HEADS + h) * 64 + kb) * 2 + s) * 4 + db) * 64 + hh * 32 + dl) * 8; }
struct EpiProj {
    bf16_t *Qs, *Kf, *Vf, *GA, *U, *GB; const LAS float* rsl;
    __device__ __forceinline__ void operator()(const f32x4 (&acc)[2][2][4][2], const pg8::Unit& u, int wr, int wc, int fr, int fq) const {
        bf16_t* base; int roff[2][4], coff[2];
        if (u.kind == 1) {
            base = Kf;
#pragma unroll
            for (int ai = 0; ai < 2; ++ai)
#pragma unroll
                for (int m = 0; m < 4; ++m) { const int tok = u.pm * 256 + ai * 128 + wr * 64 + m * 16 + fr; roff[ai][m] = ((tok >> 11) * A_HEADS * 64 + ((tok & 2047) >> 5)) * 4096 + (tok & 31) * 8; }
#pragma unroll
            for (int bj = 0; bj < 2; ++bj) coff[bj] = (2 * u.pn + bj) * 64 * 4096 + (2 * wc + (fq >> 1)) * 512 + (fq & 1) * 256;
        } else if (u.kind == 2) {
            base = Vf;
#pragma unroll
            for (int ai = 0; ai < 2; ++ai)
#pragma unroll
                for (int m = 0; m < 4; ++m) { const int vcol = u.pm * 256 + ai * 128 + wr * 64 + m * 16 + fr, d = vcol & 127; roff[ai][m] = (vcol >> 7) * 64 * 4096 + (d >> 5) * 512 + (d & 31) * 8; }
#pragma unroll
            for (int bj = 0; bj < 2; ++bj) { const int tok0 = u.pn * 256 + bj * 128 + wc * 32; coff[bj] = ((tok0 >> 11) * A_HEADS * 64 + ((tok0 & 2047) >> 5)) * 4096 + (fq >> 1) * 2048 + (fq & 1) * 256; }
        } else {
            base = u.kind == 0 ? Qs : (u.kind == 3 ? GA : (u.kind == 4 ? U : GB));
#pragma unroll
            for (int ai = 0; ai < 2; ++ai)
#pragma unroll
                for (int m = 0; m < 4; ++m) roff[ai][m] = (u.pm * 256 + ai * 128 + wr * 64 + m * 16 + fr) * A_WIDTH;
#pragma unroll
            for (int bj = 0; bj < 2; ++bj) coff[bj] = u.pn * 256 + wc * 32 + 8 * fq + bj * 128;
        }
        const bool act = (u.kind == 3) || (u.kind == 5); const float sc = (u.kind == 0) ? QSCALE : 1.f;
        float rrow[2][4]; f32x4 rc0[2], rc1[2];
        if (u.kind == 2) {
#pragma unroll
            for (int bj = 0; bj < 2; ++bj) { const LAS float* rp = rsl + bj * 128 + wc * 32 + 16 * (fq >> 1) + 4 * (fq & 1); rc0[bj] = *(const LAS f32x4*)rp; rc1[bj] = *(const LAS f32x4*)(rp + 8); }
#pragma unroll
            for (int ai = 0; ai < 2; ++ai)
#pragma unroll
                for (int m = 0; m < 4; ++m) rrow[ai][m] = 1.f;
        } else {
#pragma unroll
            for (int ai = 0; ai < 2; ++ai)
#pragma unroll
                for (int m = 0; m < 4; ++m) rrow[ai][m] = rsl[ai * 128 + wr * 64 + m * 16 + fr] * sc;
#pragma unroll
            for (int bj = 0; bj < 2; ++bj) { rc0[bj] = (f32x4){1.f, 1.f, 1.f, 1.f}; rc1[bj] = rc0[bj]; }
        }
#pragma unroll
        for (int ai = 0; ai < 2; ++ai)
#pragma unroll
            for (int m = 0; m < 4; ++m)
#pragma unroll
                for (int bj = 0; bj < 2; ++bj) { f32x4 v0 = acc[ai][bj][m][0] * rrow[ai][m] * rc0[bj], v1 = acc[ai][bj][m][1] * rrow[ai][m] * rc1[bj];
                    if (act) {
#pragma unroll
                        for (int e = 0; e < 4; ++e) { v0[e] = silu_fast(v0[e]); v1[e] = silu_fast(v1[e]); } }
                    u32x4 w; w.x = pg8::cvt_pk_bf16(v0[0], v0[1]); w.y = pg8::cvt_pk_bf16(v0[2], v0[3]); w.z = pg8::cvt_pk_bf16(v1[0], v1[1]); w.w = pg8::cvt_pk_bf16(v1[2], v1[3]);
                    *(u32x4*)(base + (size_t)(unsigned)(roff[ai][m] + coff[bj])) = w; }
    }
};

template <int W> __device__ __forceinline__ void pool_dtile_w(const bf16_t* __restrict__ up, bf16_t* __restrict__ dp, int tp0, int nchunk) {
    constexpr int NT = 16, NR = W - 1 + NT;
    const float iw = 1.f / (float)W;
    (void)nchunk;
    u32x4 r[NR];
#pragma unroll
    for (int i = 0; i < NR; ++i) { int rel = i - (W - 1); rel = rel < -tp0 ? -tp0 : rel; r[i] = *(const u32x4*)(up + (ptrdiff_t)rel * B_WIDTH); }
#pragma unroll
    for (int i = 0; i < W - 1; ++i) { const bool ok = (tp0 + i - (W - 1)) >= 0; r[i].x = ok ? r[i].x : 0u; r[i].y = ok ? r[i].y : 0u; r[i].z = ok ? r[i].z : 0u; r[i].w = ok ? r[i].w : 0u; }
    float sm[8];
#pragma unroll
    for (int e = 0; e < 8; ++e) sm[e] = 0.f;
#define POOL_ACC(raw_, sgn_) do { sm[0] += sgn_ bflo(raw_.x); sm[1] += sgn_ bfhi(raw_.x); sm[2] += sgn_ bflo(raw_.y); sm[3] += sgn_ bfhi(raw_.y); sm[4] += sgn_ bflo(raw_.z); sm[5] += sgn_ bfhi(raw_.z); sm[6] += sgn_ bflo(raw_.w); sm[7] += sgn_ bfhi(raw_.w); } while (0)
#pragma unroll
    for (int i = 0; i < W - 1; ++i) POOL_ACC(r[i], +);
#pragma unroll
    for (int k = 0; k < NT; ++k) {
        const u32x4 cur = r[W - 1 + k]; POOL_ACC(cur, +);
        if (k > 0) POOL_ACC(r[k - 1], -);
        const int tp = tp0 + k; const float ic = (tp + 1 >= W) ? iw : 1.f / (float)(tp + 1);
        u32x4 o; o.x = pk2(sm[0] * ic - bflo(cur.x), sm[1] * ic - bfhi(cur.x)); o.y = pk2(sm[2] * ic - bflo(cur.y), sm[3] * ic - bfhi(cur.y));
        o.z = pk2(sm[4] * ic - bflo(cur.z), sm[5] * ic - bfhi(cur.z)); o.w = pk2(sm[6] * ic - bflo(cur.w), sm[7] * ic - bfhi(cur.w));
        store16_wt(dp + (size_t)k * B_GD, o);
    }
#undef POOL_ACC
}

struct Frame {
    LAS unsigned char* lds;
    int tid, lane, wave, G, gw, NGW;
};

__device__ __forceinline__ void p0_transpose_item(const float* W, int K, int N, bf16_t* WT, LAS float* scr, int item, int lane, const float* kscale = nullptr) {
    const int nblk = N / 32, kb = item / nblk, nb = item % nblk, k0 = 64 * kb, n0 = 32 * nb;
    f32x4 ld[8];
#pragma unroll
    for (int i = 0; i < 8; ++i) ld[i] = __builtin_nontemporal_load((const f32x4*)(W + (size_t)(k0 + 8 * i + (lane >> 3)) * N + n0 + 4 * (lane & 7)));
#pragma unroll
    for (int i = 0; i < 8; ++i) { LAS float* d = scr + (8 * i + (lane >> 3)) * 33 + 4 * (lane & 7); d[0] = ld[i][0]; d[1] = ld[i][1]; d[2] = ld[i][2]; d[3] = ld[i][3]; }
    LDS_WAIT(); asm volatile("" ::: "memory");
    const int c = lane & 7;
    f32x4 k0s = {1.f, 1.f, 1.f, 1.f}, k1s = {1.f, 1.f, 1.f, 1.f};
    if (kscale) { k0s = *(const f32x4*)(kscale + k0 + 8 * c); k1s = *(const f32x4*)(kscale + k0 + 8 * c + 4); }
#pragma unroll
    for (int j = 0; j < 4; ++j) { const int n = (lane >> 3) + 8 * j; const LAS float* s = scr + (8 * c) * 33 + n;
        u32x4 o; o.x = pk2(s[0 * 33] * k0s[0], s[1 * 33] * k0s[1]); o.y = pk2(s[2 * 33] * k0s[2], s[3 * 33] * k0s[3]); o.z = pk2(s[4 * 33] * k1s[0], s[5 * 33] * k1s[1]); o.w = pk2(s[6 * 33] * k1s[2], s[7 * 33] * k1s[3]);
        *(u32x4*)(WT + (size_t)(n0 + n) * K + k0 + 8 * c) = o; }
    LDS_WAIT(); asm volatile("" ::: "memory");
}
template <int NR> __device__ __forceinline__ void rms_rows_to_bf16(const float* const (&xrow)[NR], const LAS f32x4* g, bf16_t* const (&orow)[NR], int lane) {
    f32x4 v[NR][16];
#pragma unroll
    for (int r = 0; r < NR; ++r)
#pragma unroll
        for (int j = 0; j < 16; ++j) v[r][j] = __builtin_nontemporal_load((const f32x4*)xrow[r] + lane + 64 * j);
#pragma unroll
    for (int r = 0; r < NR; ++r) { float s = 0.f;
#pragma unroll
        for (int j = 0; j < 16; ++j) s += (v[r][j].x * v[r][j].x + v[r][j].y * v[r][j].y) + (v[r][j].z * v[r][j].z + v[r][j].w * v[r][j].w);
        const float rs = rsqrtf(wave_sum_f(s) * (1.f / D_MODEL) + EPS);
        unsigned long long* o8 = (unsigned long long*)orow[r] + lane;
#pragma unroll
        for (int j = 0; j < 16; ++j) { const f32x4 gg = g[lane + 64 * j];
            o8[64 * j] = (unsigned long long)pk2(v[r][j].x * rs * gg.x, v[r][j].y * rs * gg.y) | ((unsigned long long)pk2(v[r][j].z * rs * gg.z, v[r][j].w * rs * gg.w) << 32); } }
}

template <int NR> __device__ __forceinline__ void x_rows_to_bf16_raw(const float* const (&xrow)[NR], bf16_t* const (&orow)[NR], float* const (&rsout)[NR], int lane) {
    f32x4 v[NR][16];
#pragma unroll
    for (int r = 0; r < NR; ++r)
#pragma unroll
        for (int j = 0; j < 16; ++j) v[r][j] = __builtin_nontemporal_load((const f32x4*)xrow[r] + lane + 64 * j);
#pragma unroll
    for (int r = 0; r < NR; ++r) { float s = 0.f;
#pragma unroll
        for (int j = 0; j < 16; ++j) s += (v[r][j].x * v[r][j].x + v[r][j].y * v[r][j].y) + (v[r][j].z * v[r][j].z + v[r][j].w * v[r][j].w);
        const float rs = rsqrtf(wave_sum_f(s) * (1.f / D_MODEL) + EPS);
        if (lane == 0) *rsout[r] = rs;
        unsigned long long* o8 = (unsigned long long*)orow[r] + lane;
#pragma unroll
        for (int j = 0; j < 16; ++j) o8[64 * j] = (unsigned long long)pk2(v[r][j].x, v[r][j].y) | ((unsigned long long)pk2(v[r][j].z, v[r][j].w) << 32); }
}

struct Args { const float* in[16]; float* out; unsigned char* ws; };

__global__ void __launch_bounds__(NWAVES * 64, 2) mk_fwd(Args args) {
    extern __shared__ __attribute__((aligned(16))) unsigned char lds_raw[];
    Frame F;
    F.lds = (LAS unsigned char*)lds_raw;
    F.tid = threadIdx.x; F.lane = F.tid & 63; F.wave = __builtin_amdgcn_readfirstlane(F.tid >> 6);
    F.G = gridDim.x; F.gw = (int)blockIdx.x * NWAVES + F.wave; F.NGW = F.G * NWAVES;
    volatile LAS unsigned* MISC = (volatile LAS unsigned*)(F.lds + MISC_OFF);
    unsigned char* ws = args.ws;
    for (int u = F.tid; u < (LDS_BYTES - LDSCTL_OFF) / 4; u += NWAVES * 64) ((LAS unsigned*)(F.lds + LDSCTL_OFF))[u] = 0u;
    __syncthreads();
    XcdBarrier bar = xcd_barrier_post((unsigned*)(ws + WS_CTL) + CW_BAR, MISC + 8);
#define GRID_BAR() xcd_barrier(bar)
#define PHASE_BEGIN(k) for (int rep_ = 0; rep_ <= ((PROBE_MASK >> (k)) & 1); ++rep_) {
#define PHASE_END() GRID_BAR(); }
#define PHASE_END_NOBAR() }

    const float* x = args.in[0]; const float* mem = args.in[1]; const float* g_mix_pre = args.in[2]; const float* w_in = args.in[3];
    const float* rel_bias = args.in[4]; const float* w_pool = args.in[5]; const float* pool_scale = args.in[6]; const float* w_out = args.in[7];
    const float* g_mix_post = args.in[8]; const float* g_xa_pre = args.in[9]; const float* g_mem = args.in[10]; const float* w_xq = args.in[11];
    const float* w_xk = args.in[12]; const float* w_xv = args.in[13]; const float* w_xo = args.in[14]; const float* g_xa_post = args.in[15];
    float* out = args.out;
    bf16_t* WinT = (bf16_t*)(ws + WS_WINT); bf16_t* WoutT = (bf16_t*)(ws + WS_WOUTT); bf16_t* WxqT = (bf16_t*)(ws + WS_WXQT); bf16_t* WxkT = (bf16_t*)(ws + WS_WXKT);
    bf16_t* WxvT = (bf16_t*)(ws + WS_WXVT); bf16_t* WxoT = (bf16_t*)(ws + WS_WXOT); bf16_t* WpT = (bf16_t*)(ws + WS_WPT);
    bf16_t* H = (bf16_t*)(ws + WS_H); bf16_t* Mn = (bf16_t*)(ws + WS_MN); bf16_t* YCAT = (bf16_t*)(ws + WS_YCAT);
    bf16_t* Qs = (bf16_t*)(ws + WS_QS); bf16_t* Kf = (bf16_t*)(ws + WS_KF); bf16_t* Vf = (bf16_t*)(ws + WS_VF); bf16_t* GA = (bf16_t*)(ws + WS_GA); bf16_t* U = (bf16_t*)(ws + WS_U); bf16_t* GB = (bf16_t*)(ws + WS_GB);
    bf16_t* X1b = (bf16_t*)(ws + WS_X1); bf16_t* Dscr = (bf16_t*)(ws + WS_DSCR);
    bf16_t* Qp = (bf16_t*)(ws + WS_QP); bf16_t* KXf = (bf16_t*)(ws + WS_KXF); bf16_t* VXf = (bf16_t*)(ws + WS_VXF); bf16_t* O = (bf16_t*)(ws + WS_O); bf16_t* XS = (bf16_t*)(ws + WS_XS);
    LAS float* scr = (LAS float*)(F.lds + RING_OFF + F.wave * 16384);

    PHASE_BEGIN(0)
    {
        const int lane = launder_i(F.lane);
        constexpr int I_IN = (D_MODEL / 64) * (IN_COLS / 32), I_OUT = (D_MODEL / 64) * (D_MODEL / 32), I_XQ = (D_MODEL / 64) * (XA_WIDTH / 32), I_XO = (XA_WIDTH / 64) * (D_MODEL / 32), I_P = (B_GD / 64) * (B_GD / 32);
        constexpr int NITEMS = I_IN + I_OUT + 3 * I_XQ + I_XO + 4 * I_P;
        for (int it = F.gw; it < NITEMS; it += F.NGW) {
            int r = it;
            if (r < I_IN) { p0_transpose_item(w_in, D_MODEL, IN_COLS, WinT, scr, r, lane, g_mix_pre); continue; } r -= I_IN;
            if (r < I_OUT) { p0_transpose_item(w_out, D_MODEL, D_MODEL, WoutT, scr, r, lane); continue; } r -= I_OUT;
            if (r < I_XQ) { p0_transpose_item(w_xq, D_MODEL, XA_WIDTH, WxqT, scr, r, lane, g_xa_pre); continue; } r -= I_XQ;
            if (r < I_XQ) { p0_transpose_item(w_xk, D_MODEL, XA_WIDTH, WxkT, scr, r, lane); continue; } r -= I_XQ;
            if (r < I_XQ) { p0_transpose_item(w_xv, D_MODEL, XA_WIDTH, WxvT, scr, r, lane); continue; } r -= I_XQ;
            if (r < I_XO) { p0_transpose_item(w_xo, XA_WIDTH, D_MODEL, WxoT, scr, r, lane); continue; } r -= I_XO;
            const int g = r / I_P; p0_transpose_item(w_pool + (size_t)g * B_GD * B_GD, B_GD, B_GD, WpT + (size_t)g * B_GD * B_GD, scr, r % I_P, lane);
        }
        __syncthreads();
        { LAS f32x4* gl = (LAS f32x4*)(F.lds + RING_OFF);
          for (int i = launder_i(F.tid); i < 2048; i += NWAVES * 64) gl[i] = (i < 1024) ? ((const f32x4*)g_mix_pre)[i] : ((const f32x4*)g_mem)[i - 1024]; }
        __syncthreads();
        { const LAS f32x4* gx = (const LAS f32x4*)(F.lds + RING_OFF); const LAS f32x4* gm = gx + 1024;
          for (int m = 2 * F.gw; m < NTOK; m += 2 * F.NGW) {
              const float* const xr[2] = {x + (size_t)m * D_MODEL, x + (size_t)(m + 1) * D_MODEL}; bf16_t* const orow[2] = {H + (size_t)m * D_MODEL, H + (size_t)(m + 1) * D_MODEL};
              float* const rso[2] = {(float*)(ws + WS_RS0) + m, (float*)(ws + WS_RS0) + m + 1};
              x_rows_to_bf16_raw<2>(xr, orow, rso, lane); }
          for (int m = F.gw; m < NMTOK; m += F.NGW) { const float* const xr[1] = {mem + (size_t)m * D_MODEL}; bf16_t* const orow[1] = {Mn + (size_t)m * D_MODEL}; rms_rows_to_bf16<1>(xr, gm, orow, lane); } }
    }
    PHASE_END()

    PHASE_BEGIN(1)
    {
        ProjSched S; S.H = H; S.WinT = WinT; S.so.init(NTOK, IN_COLS, F.G, (int)blockIdx.x);
        EpiProj E; E.Qs = Qs; E.Kf = Kf; E.Vf = Vf; E.GA = GA; E.U = U; E.GB = GB;
        { LAS float* rsl = (LAS float*)(F.lds + RING_BYTES + 16384); Order2 o0; S.so.next(0, o0);
          const int tid = launder_i(F.tid); if (tid < 256) rsl[tid] = ((const float*)(ws + WS_RS0))[o0.pm * 256 + tid];
          __syncthreads(); E.rsl = rsl; }
        pg8::Geom g; g.K = D_MODEL; g.lda = D_MODEL; g.ldb = D_MODEL;
        pg8::gemm_phase(F.lds + RING_OFF, g, S, E);
    }
    PHASE_END()

    PHASE_BEGIN(2)
    {
        const int lane = launder_i(F.lane);
        for (int rep2_ = 0; rep2_ <= ((PROBE_MASK >> 11) & 1); ++rep2_)
        {
            const int w = F.wave, hh = w >> 2, ci = (w >> 1) & 1, qh = w & 1, r32 = lane & 31, hi = lane >> 5, kvsel = (w >> 1) & 1;
            LAS unsigned char* ring = F.lds + RING_OFF;
            LAS float* btab = (LAS float*)(F.lds + BIAS_OFF);
#define ATT_WAIT_V(n) asm volatile("s_waitcnt vmcnt(" #n ")" ::: "memory")
#define ATT_BAR() do { asm volatile("s_waitcnt lgkmcnt(0)" ::: "memory"); __builtin_amdgcn_s_barrier(); asm volatile("" ::: "memory"); } while (0)
            bf16x8 qf[8];
#define ATT_LOADQ(ui_) do { const int u_ = (ui_), lq = launder_i(lane); \
                const bf16_t* qp = Qs + ((size_t)(u_ >> 7) * SEQ + (2 * ((u_ >> 3) & 15) + ci) * CHUNK + 32 * qh + (lq & 31)) * A_WIDTH + (2 * (u_ & 7) + hh) * A_HD + 8 * (lq >> 5); \
                _Pragma("unroll") for (int st = 0; st < 8; ++st) qf[st] = *(const bf16x8*)(qp + 16 * st); } while (0)
            ATT_LOADQ((int)blockIdx.x);
            for (int ui = (int)blockIdx.x; ui < 512; ui += F.G) {
                const int hp = ui & 7, cp = (ui >> 3) & 15, b = ui >> 7;
                const int c0 = 2 * cp, h0 = 2 * hp, h = h0 + hh, c = c0 + ci;
                const int kc_lo = c0 >= 8 ? c0 - 8 : 0, nst = 2 * (c0 + 2 - kc_lo);
                const bf16_t* src0 = (kvsel ? Vf : Kf) + ((size_t)(b * A_HEADS + h) * 64 + 2 * kc_lo) * 4096 + (4 * qh) * 512 + launder_i(lane) * 8;
                const unsigned dst0 = (unsigned)(hh * 16384 + kvsel * 8192 + (4 * qh) * 1024);
                const int nch = nst >> 1, rot = (c0 >= 8) ? (10 - kc_lo % 10) % 10 : 0;
#define ATT_VB(q_) (2 * ((((q_) >> 1) + rot) >= nch ? ((q_) >> 1) + rot - nch : ((q_) >> 1) + rot) + ((q_) & 1))
#define ATT_STAGE(s_) do { const bf16_t* sp_ = src0 + (size_t)ATT_VB(s_) * 4096; const unsigned d_ = (unsigned)(((s_) & 3) * 32768) + dst0; \
                    _Pragma("unroll") for (int i_ = 0; i_ < 4; ++i_) __builtin_amdgcn_global_load_lds((const unsigned*)(sp_ + i_ * 512), (LAS unsigned*)(ring + d_ + i_ * 1024), 16, 0, 0); } while (0)
                ATT_STAGE(0); ATT_STAGE(1); ATT_STAGE(2);
                if (ui == (int)blockIdx.x)
                    for (int i = F.tid; i < 1536; i += NWAVES * 64) { const int e = i >= 768 ? 1 : 0, idx = 703 - (i - 768 * e); const float* rb = rel_bias + (h0 + e) * REL_SIZE;
                        btab[i] = (idx < 0 || idx >= 640) ? -3.0e38f : (rb[idx < 191 ? idx : 191] - rb[191]) * 1.4426950408889634f; }
                const LAS float* bp0 = btab + hh * 768 + 703 - (32 * qh + r32 + 575 - 4 * hi - 64 * (kc_lo - c + 8));
                const int s_lo = (ci == 1 && c0 >= 8) ? 2 : 0, s_hi = (ci == 0) ? nst - 2 : nst;
                const LAS float* bpm = btab + hh * 768;
#define ATT_BP(q_) ((ATT_VB(q_) >= s_lo && ATT_VB(q_) < s_hi) ? bp0 + 32 * ATT_VB(q_) : bpm)
                float m_run = -1e30f, l_run = 0.f;
                f32x16 o[4];
#pragma unroll
                for (int db = 0; db < 4; ++db)
#pragma unroll
                    for (int r = 0; r < 16; ++r) o[db][r] = 0.f;
                f32x16 sA, sB;
#define ATT_MAX3(d_, a_, b_, c_) asm("v_max3_f32 %0, %1, %2, %3" : "=v"(d_) : "v"(a_), "v"(b_), "v"(c_))
#define ATT_CVT(d_, a_, b_) do { typedef __bf16 bf2_ __attribute__((ext_vector_type(2))); typedef float f2_ __attribute__((ext_vector_type(2))); f2_ t_; t_[0] = (a_); t_[1] = (b_); d_ = __builtin_bit_cast(unsigned, __builtin_convertvector(t_, bf2_)); } while (0)
#define ATT_QK_LOADS(q_, S_, BP_) const LAS bf16x8* kp_ = (const LAS bf16x8*)(ring + ((q_) & 3) * 32768 + hh * 16384) + lane; bf16x8 kf_[8]; \
                    _Pragma("unroll") for (int st = 0; st < 8; ++st) kf_[st] = kp_[st * 64]; \
                    { const LAS float* bp_ = (BP_); _Pragma("unroll") for (int r = 0; r < 16; ++r) S_[r] = bp_[(r & 3) + 8 * (r >> 2)]; }
#define ATT_PV_LOADS(p_) const LAS bf16x8* vp_ = (const LAS bf16x8*)(ring + ((p_) & 3) * 32768 + hh * 16384 + 8192) + lane; bf16x8 vf_[8]; \
                    _Pragma("unroll") for (int i = 0; i < 8; ++i) vf_[i] = vp_[i * 64];
#define ATT_QK_MFMA(S_) _Pragma("unroll") for (int st = 0; st < 8; ++st) S_ = __builtin_amdgcn_mfma_f32_32x32x16_bf16(kf_[st], qf[st], S_, 0, 0, 0);
#define ATT_SOFTMAX(S_) float ps0_ = 0.f; \
                    _Pragma("unroll") for (int r = 0; r < 16; ++r) { S_[r] = __builtin_amdgcn_exp2f(S_[r] - m_run); ps0_ += S_[r]; } \
                    bf16x8 pf_[2]; _Pragma("unroll") for (int s2 = 0; s2 < 2; ++s2) { u32x4 pw_; ATT_CVT(pw_.x, S_[8 * s2 + 0], S_[8 * s2 + 1]); ATT_CVT(pw_.y, S_[8 * s2 + 2], S_[8 * s2 + 3]); \
                        ATT_CVT(pw_.z, S_[8 * s2 + 4], S_[8 * s2 + 5]); ATT_CVT(pw_.w, S_[8 * s2 + 6], S_[8 * s2 + 7]); pf_[s2] = __builtin_bit_cast(bf16x8, pw_); }
#define ATT_PV_MFMA() _Pragma("unroll") for (int s2 = 0; s2 < 2; ++s2) _Pragma("unroll") for (int db = 0; db < 4; ++db) o[db] = __builtin_amdgcn_mfma_f32_32x32x16_bf16(vf_[s2 * 4 + db], pf_[s2], o[db], 0, 0, 0);
#define ATT_NEWMAX(S_) { float a_, b_, c_, d_, e_; ATT_MAX3(a_, S_[0], S_[1], S_[2]); ATT_MAX3(b_, S_[3], S_[4], S_[5]); ATT_MAX3(c_, S_[6], S_[7], S_[8]); ATT_MAX3(d_, S_[9], S_[10], S_[11]); \
                    ATT_MAX3(e_, S_[12], S_[13], S_[14]); ATT_MAX3(a_, a_, b_, c_); ATT_MAX3(d_, d_, e_, S_[15]); float mx_; ATT_MAX3(mx_, a_, d_, d_); \
                    { const auto sw_ = __builtin_amdgcn_permlane32_swap(__float_as_uint(mx_), __float_as_uint(mx_), false, false); float x0_ = __uint_as_float(sw_[0]), x1_ = __uint_as_float(sw_[1]); ATT_MAX3(mx_, x0_, x1_, x1_); } \
                    if (!__all(mx_ <= m_run + 8.f)) { const float mn_ = fmaxf(m_run, mx_), alpha_ = __builtin_amdgcn_exp2f(m_run - mn_); \
                        _Pragma("unroll") for (int db = 0; db < 4; ++db) _Pragma("unroll") for (int r = 0; r < 16; ++r) o[db][r] *= alpha_; \
                        l_run *= alpha_; m_run = mn_; } }
#define ATT_SYNC(q_) do { if ((q_) + 1 < nst) ATT_WAIT_V(4); else ATT_WAIT_V(0); ATT_BAR(); if ((q_) + 2 < nst) ATT_STAGE((q_) + 2); } while (0)
#define ATT_BOTH(q_, NXT_, CUR_, BP_) do { ATT_QK_LOADS(q_, NXT_, BP_) __builtin_amdgcn_sched_barrier(0); \
                        ATT_SOFTMAX(CUR_) ATT_QK_MFMA(NXT_) ATT_PV_LOADS((q_) - 1) \
                        __builtin_amdgcn_sched_group_barrier(0x008, 1, 0); __builtin_amdgcn_sched_group_barrier(0x402, 7, 0); \
                        _Pragma("unroll") for (int g_ = 0; g_ < 7; ++g_) { __builtin_amdgcn_sched_group_barrier(0x008, 1, 0); __builtin_amdgcn_sched_group_barrier(0x100, 1, 0); __builtin_amdgcn_sched_group_barrier(0x402, 7, 0); } \
                        __builtin_amdgcn_sched_group_barrier(0x100, 1, 0); \
                        __builtin_amdgcn_sched_barrier(0); ATT_PV_MFMA() l_run += ps0_; ATT_NEWMAX(NXT_) } while (0)
#define ATT_QKONLY(q_, NXT_) do { ATT_QK_LOADS(q_, NXT_, ATT_BP(q_)) __builtin_amdgcn_sched_barrier(0); ATT_QK_MFMA(NXT_) ATT_NEWMAX(NXT_) } while (0)
#define ATT_SMONLY(p_, CUR_) do { ATT_PV_LOADS(p_) __builtin_amdgcn_sched_barrier(0); ATT_SOFTMAX(CUR_) ATT_PV_MFMA() l_run += ps0_; } while (0)
                ATT_WAIT_V(8); ATT_BAR();
                ATT_QKONLY(0, sA);
#pragma unroll 1
                for (int q = 1; q < nst - 3; q += 2) {
                    ATT_SYNC(q); ATT_BOTH(q, sB, sA, ATT_BP(q));
                    ATT_SYNC(q + 1); ATT_BOTH(q + 1, sA, sB, ATT_BP(q + 1));
                }
                ATT_SYNC(nst - 3); ATT_BOTH(nst - 3, sB, sA, ATT_BP(nst - 3));
                ATT_SYNC(nst - 2); ATT_BOTH(nst - 2, sA, sB, ATT_BP(nst - 2));
                ATT_SYNC(nst - 1); ATT_BOTH(nst - 1, sB, sA, ATT_BP(nst - 1));
                ATT_SMONLY(nst - 1, sB);
#undef ATT_SYNC
#undef ATT_BP
#undef ATT_BOTH
#undef ATT_QKONLY
#undef ATT_SMONLY
#undef ATT_NEWMAX
#undef ATT_PV_MFMA
#undef ATT_SOFTMAX
#undef ATT_QK_MFMA
#undef ATT_PV_LOADS
#undef ATT_QK_LOADS
#undef ATT_CVT
#undef ATT_MAX3
                ATT_BAR();
                if (ui + F.G < 512) ATT_LOADQ(ui + F.G);
                const float inv = 1.f / (l_run + __shfl_xor(l_run, 32));
                { LAS unsigned char* scw = ring + w * 16384 + r32 * 512;
#pragma unroll
                  for (int db = 0; db < 4; ++db)
#pragma unroll
                      for (int g4 = 0; g4 < 4; ++g4) { f32x4 v_; v_[0] = o[db][4 * g4 + 0] * inv; v_[1] = o[db][4 * g4 + 1] * inv; v_[2] = o[db][4 * g4 + 2] * inv; v_[3] = o[db][4 * g4 + 3] * inv;
                          *(LAS f32x4*)(scw + (((8 * db + 2 * g4 + hi) ^ r32) << 4)) = v_; } }
                { const int le = launder_i(lane), qr = le >> 4, k8 = le & 15;
                  const size_t orow = (size_t)b * SEQ + c * CHUNK + 32 * qh + qr;
                  const bf16_t* gap = GA + orow * A_WIDTH + h * A_HD + 8 * k8;
                  bf16_t* yp = YCAT + orow * D_MODEL + h * A_HD + 8 * k8;
                  u32x4 gr[8];
#pragma unroll
                  for (int i = 0; i < 8; ++i) gr[i] = *(const u32x4*)(gap + (size_t)(4 * i) * A_WIDTH);
                  const LAS unsigned char* scr_ = ring + w * 16384;
#pragma unroll
                  for (int i = 0; i < 8; ++i) { const int q_ = 4 * i + qr; const LAS unsigned char* rp_ = scr_ + q_ * 512 + (((2 * k8) ^ q_) << 4);
                      const f32x4 a0 = *(const LAS f32x4*)rp_, a1 = *(const LAS f32x4*)((const LAS unsigned char*)((unsigned)(size_t)rp_ ^ 16u));
                      u32x4 ov; ov.x = pg8::cvt_pk_bf16(a0[0] * bflo(gr[i].x), a0[1] * bfhi(gr[i].x)); ov.y = pg8::cvt_pk_bf16(a0[2] * bflo(gr[i].y), a0[3] * bfhi(gr[i].y));
                      ov.z = pg8::cvt_pk_bf16(a1[0] * bflo(gr[i].z), a1[1] * bfhi(gr[i].z)); ov.w = pg8::cvt_pk_bf16(a1[2] * bflo(gr[i].w), a1[3] * bfhi(gr[i].w));
                      store16_wt(yp + (size_t)(4 * i) * D_MODEL, ov); } }
                asm volatile("s_waitcnt vmcnt(0)" ::: "memory");
                ATT_BAR();
                if (F.tid == 0) (void)xb_add((unsigned*)(ws + WS_CTL) + CW_FY + (b * 8 + (cp >> 1)) * 16, 1u);
            }
#undef ATT_STAGE
#undef ATT_LOADQ
#undef ATT_VB
#undef ATT_WAIT_V
#undef ATT_BAR
        }
    }
    for (int rep2_ = 0; rep2_ <= ((PROBE_MASK >> 12) & 1); ++rep2_)
    {
        const int L = (int)blockIdx.x;
        for (int rep3_ = 0; rep3_ <= ((PROBE_MASK >> 14) & 1); ++rep3_)
        if (L < 256) {
            const int tid = launder_i(F.tid), cg = tid & 63, sg = tid >> 6, g = L >> 6, pn = (L >> 5) & 1, pm = L & 31;
            const int row0 = pm * 256 + pn * 128 + sg * 16, tp0 = row0 & (SEQ - 1);
            const bf16_t* up = U + (size_t)row0 * B_WIDTH + g * B_GD + cg * 8;
            bf16_t* dp = Dscr + ((size_t)(g * 32 + pm) * 256 + pn * 128 + sg * 16) * B_GD + cg * 8;
            if (g == 0) pool_dtile_w<2>(up, dp, tp0, 2); else if (g == 1) pool_dtile_w<4>(up, dp, tp0, 2); else if (g == 2) pool_dtile_w<8>(up, dp, tp0, 2); else pool_dtile_w<16>(up, dp, tp0, 2);
        }
        { unsigned* fd = (unsigned*)(ws + WS_CTL) + CW_FD + ((L >> 6) * 32 + (L & 31)) * 16;
          handoff_signal(fd); handoff_wait(fd, 2u, (unsigned*)(ws + WS_CTL) + CW_BAR); }
        PoolSched S; S.Dscr = Dscr; S.WpT = WpT; S.G = F.G; S.c = (int)blockIdx.x;
        EpiPool E; E.pool_scale = pool_scale; E.GB = GB; E.YCAT = YCAT;
        pg8::Geom g; g.K = B_GD; g.lda = B_GD; g.ldb = B_GD;
        for (int rep3_ = 0; rep3_ <= ((PROBE_MASK >> 15) & 1); ++rep3_)
        pg8::gemm_phase(F.lds + RING_OFF, g, S, E);
        handoff_signal((unsigned*)(ws + WS_CTL) + CW_FY + (L & 31) * 16);
    }
    for (int rep2_ = 0; rep2_ <= ((PROBE_MASK >> 13) & 1); ++rep2_)
    {
        XkvSched S; S.Mn = Mn; S.WxkvT = WxkT; S.G = F.G; S.c = (int)blockIdx.x;
        XkvEpi E; E.XS = XS;
        pg8::Geom g; g.K = 512; g.lda = D_MODEL; g.ldb = D_MODEL;
        pg8::gemm_phase(F.lds + RING_OFF, g, S, E);
        { const int L = (int)blockIdx.x; handoff_signal((unsigned*)(ws + WS_CTL) + CW_FX + ((L >> 6) * 4 + ((L >> 3) & 3)) * 16); }
    }
    PHASE_END_NOBAR()

    PHASE_BEGIN(5)
    {
        handoff_wait((unsigned*)(ws + WS_CTL) + CW_FX + ((int)blockIdx.x >> 4) * 16, 16u, (unsigned*)(ws + WS_CTL) + CW_BAR);
        const int tid = launder_i(F.tid);
        for (size_t i8 = (size_t)blockIdx.x * (NWAVES * 64) + tid; i8 < 2 * XF_ELEMS / 8; i8 += (size_t)F.G * (NWAVES * 64)) {
            const bf16_t* p = XS + i8 * 8;
            u32x4 t[8];
#pragma unroll
            for (int sl = 0; sl < 8; ++sl) t[sl] = *(const u32x4*)(p + (size_t)sl * 2 * XF_ELEMS);
            f32x4 a0 = {0.f, 0.f, 0.f, 0.f}, a1 = {0.f, 0.f, 0.f, 0.f};
#pragma unroll
            for (int sl = 0; sl < 8; ++sl) { a0.x += bflo(t[sl].x); a0.y += bfhi(t[sl].x); a0.z += bflo(t[sl].y); a0.w += bfhi(t[sl].y); a1.x += bflo(t[sl].z); a1.y += bfhi(t[sl].z); a1.z += bflo(t[sl].w); a1.w += bfhi(t[sl].w); }
            u32x4 o; o.x = pk2(a0.x, a0.y); o.y = pk2(a0.z, a0.w); o.z = pk2(a1.x, a1.y); o.w = pk2(a1.z, a1.w);
            store16_wt(KXf + i8 * 8, o);
        }
        handoff_signal((unsigned*)(ws + WS_CTL) + CW_FKV + ((int)blockIdx.x >> 4) * 16);
    }
    {
        { const int c = (int)blockIdx.x, pm0 = 4 * ((c & 7) >> 1) + (c >> 6); unsigned* fy = (unsigned*)(ws + WS_CTL) + CW_FY;
          handoff_wait2(fy + pm0 * 16, 24u, fy + (16 + pm0) * 16, 24u, (unsigned*)(ws + WS_CTL) + CW_BAR); }
        PanelSched S; S.A = (const char*)YCAT; S.B = (const char*)WoutT; S.a_tile = (size_t)256 * D_MODEL * 2; S.b_tile = (size_t)256 * D_MODEL * 2; S.G = F.G; S.c = (int)blockIdx.x; S.perm = 1;
        EpiX1 E; E.xb = H; E.g = g_mix_post; E.X1b = X1b; E.rss1 = (float*)(ws + WS_CTL) + CW_RSS1; E.cnt1 = (unsigned*)(ws + WS_CTL) + CW_CNT1; E.rss2 = (float*)(ws + WS_CTL) + CW_RSS2; E.xl = (LAS float*)(F.lds + XCH_OFF); E.f3 = (unsigned*)(ws + WS_CTL) + CW_F3;
        pg8::Geom g; g.K = D_MODEL; g.lda = D_MODEL; g.ldb = D_MODEL;
        pg8::gemm_phase(F.lds + RING_OFF, g, S, E);
    }
    PHASE_END_NOBAR()

    PHASE_BEGIN(7)
    {
        { const int L = (int)blockIdx.x, j = L >> 3; handoff_wait((unsigned*)(ws + WS_CTL) + CW_F3 + ((4 * (L & 7) + (j >> 3)) * 2 + (j & 1)) * 16, 8u, (unsigned*)(ws + WS_CTL) + CW_BAR); }
        QSplitSched S; S.H2 = X1b; S.WxqT = WxqT; S.G = F.G; S.c = (int)blockIdx.x;
        EpiBf16WT E; E.O = Qp; E.kstride = (size_t)NTOK * XA_WIDTH; E.ldc = XA_WIDTH;
        pg8::Geom g; g.K = 2048; g.lda = D_MODEL; g.ldb = D_MODEL;
        pg8::gemm_phase(F.lds + RING_OFF, g, S, E);
    }
    PHASE_END_NOBAR()
    {
        const int L = (int)blockIdx.x, x = L & 7, j = L >> 3, pm = 4 * x + (j >> 3), pn = (j >> 1) & 3;
        unsigned* f5 = (unsigned*)(ws + WS_CTL) + CW_F5 + (pm * 4 + pn) * 16;
        handoff_signal(f5);
        handoff_wait2(f5, 2u, (unsigned*)(ws + WS_CTL) + CW_FKV + ((pm >> 3) * 4 + pn) * 16, 16u, (unsigned*)(ws + WS_CTL) + CW_BAR);
    }

    PHASE_BEGIN(8)
    {
        const int lane = launder_i(F.lane);
        const int ql = lane & 15, g = lane >> 4, w = F.wave;
        LAS unsigned char* ring = F.lds + RING_OFF;
#define XA_WAIT_V(n) asm volatile("s_waitcnt vmcnt(" #n ")" ::: "memory")
#define XA_BAR() do { asm volatile("s_waitcnt lgkmcnt(0)" ::: "memory"); __builtin_amdgcn_s_barrier(); asm volatile("" ::: "memory"); } while (0)
#define XA_STAGE(src_, half_) do { _Pragma("unroll") for (int i_ = 0; i_ < 8; ++i_) __builtin_amdgcn_global_load_lds((const unsigned*)((src_) + (size_t)(half_) * 32768 + i_ * 512), \
            (LAS unsigned*)(ring + (half_) * 65536 + w * 8192 + i_ * 1024), 16, 0, 0); } while (0)
        for (int ui = (int)blockIdx.x; ui < 256; ui += F.G) {
            const int pm6 = 4 * (ui & 7) + (ui >> 6), hd = (ui >> 4) & 3, qb = (pm6 & 7) * 2 + ((ui >> 3) & 1), b = pm6 >> 3;
            const size_t row = (size_t)b * SEQ + qb * 128 + w * 16 + ql;
            u32x4 qa[8], qb2[8];
            { const bf16_t* qp = Qp + row * XA_WIDTH + hd * XA_HD + 8 * g;
#pragma unroll
              for (int ks = 0; ks < 8; ++ks) { qa[ks] = *(const u32x4*)(qp + 32 * ks); qb2[ks] = *(const u32x4*)(qp + (size_t)NTOK * XA_WIDTH + 32 * ks); } }
            const bf16_t* ksrc = KXf + kxf_index(b, hd, 0, 0) + (size_t)(8 * w) * 512 + lane * 8;
            const bf16_t* vsrc = VXf + vxf_index(b, hd, 0, 0) + (size_t)(8 * w) * 512 + lane * 8;
            XA_STAGE(ksrc, 0); XA_STAGE(ksrc, 1);
            bf16x8 qf[8];
            { const float QS2 = 0.0625f * 1.4426950408889634f * rsqrtf(__hip_atomic_load((float*)(ws + WS_CTL) + CW_RSS2 + row, __ATOMIC_RELAXED, __HIP_MEMORY_SCOPE_AGENT) * (1.f / D_MODEL) + EPS);
#pragma unroll
              for (int ks = 0; ks < 8; ++ks) { const u32x4 a = qa[ks], c = qb2[ks];
                  u32x4 wq; wq.x = pg8::cvt_pk_bf16((bflo(a.x) + bflo(c.x)) * QS2, (bfhi(a.x) + bfhi(c.x)) * QS2); wq.y = pg8::cvt_pk_bf16((bflo(a.y) + bflo(c.y)) * QS2, (bfhi(a.y) + bfhi(c.y)) * QS2);
                  wq.z = pg8::cvt_pk_bf16((bflo(a.z) + bflo(c.z)) * QS2, (bfhi(a.z) + bfhi(c.z)) * QS2); wq.w = pg8::cvt_pk_bf16((bflo(a.w) + bflo(c.w)) * QS2, (bfhi(a.w) + bfhi(c.w)) * QS2);
                  qf[ks] = __builtin_bit_cast(bf16x8, wq); } }
            f32x4 st[16];
            const LAS bf16x8* lfp = (const LAS bf16x8*)ring + lane;
            XA_WAIT_V(8); XA_BAR();
#pragma unroll
            for (int kb = 0; kb < 8; ++kb) { f32x4 acc = {0.f, 0.f, 0.f, 0.f};
#pragma unroll
                for (int ks = 0; ks < 8; ++ks) acc = __builtin_amdgcn_mfma_f32_16x16x32_bf16(lfp[(kb * 8 + ks) * 64], qf[ks], acc, 0, 0, 0);
                st[kb] = acc; }
            XA_BAR();
            XA_STAGE(vsrc, 0);
            XA_WAIT_V(8); XA_BAR();
#pragma unroll
            for (int kb = 0; kb < 8; ++kb) { f32x4 acc = {0.f, 0.f, 0.f, 0.f};
#pragma unroll
                for (int ks = 0; ks < 8; ++ks) acc = __builtin_amdgcn_mfma_f32_16x16x32_bf16(lfp[4096 + (kb * 8 + ks) * 64], qf[ks], acc, 0, 0, 0);
                st[8 + kb] = acc; }
            XA_BAR();
            XA_STAGE(vsrc, 1);
            float mx = -3.0e38f;
#pragma unroll
            for (int kb = 0; kb < 16; ++kb) mx = fmaxf(fmaxf(mx, fmaxf(st[kb][0], st[kb][1])), fmaxf(st[kb][2], st[kb][3]));
            mx = fmaxf(mx, __shfl_xor(mx, 16)); mx = fmaxf(mx, __shfl_xor(mx, 32));
            float l = 0.f;
#pragma unroll
            for (int kb = 0; kb < 16; ++kb)
#pragma unroll
                for (int e = 0; e < 4; ++e) { st[kb][e] = __builtin_amdgcn_exp2f(st[kb][e] - mx); l += st[kb][e]; }
            l += __shfl_xor(l, 16); l += __shfl_xor(l, 32);
            const float inv = 1.f / l;
            f32x4 o[16];
#pragma unroll
            for (int db = 0; db < 16; ++db) o[db] = (f32x4){0.f, 0.f, 0.f, 0.f};
            XA_WAIT_V(8); XA_BAR();
#pragma unroll
            for (int kstep = 0; kstep < 4; ++kstep) {
                u32x4 pw; pw.x = pg8::cvt_pk_bf16(st[2 * kstep][0], st[2 * kstep][1]); pw.y = pg8::cvt_pk_bf16(st[2 * kstep][2], st[2 * kstep][3]);
                pw.z = pg8::cvt_pk_bf16(st[2 * kstep + 1][0], st[2 * kstep + 1][1]); pw.w = pg8::cvt_pk_bf16(st[2 * kstep + 1][2], st[2 * kstep + 1][3]);
                const bf16x8 pf = __builtin_bit_cast(bf16x8, pw);
#pragma unroll
                for (int db = 0; db < 16; ++db) o[db] = __builtin_amdgcn_mfma_f32_16x16x32_bf16(lfp[(kstep * 16 + db) * 64], pf, o[db], 0, 0, 0);
            }
            XA_WAIT_V(0); XA_BAR();
#pragma unroll
            for (int kstep = 4; kstep < 8; ++kstep) {
                u32x4 pw; pw.x = pg8::cvt_pk_bf16(st[2 * kstep][0], st[2 * kstep][1]); pw.y = pg8::cvt_pk_bf16(st[2 * kstep][2], st[2 * kstep][3]);
                pw.z = pg8::cvt_pk_bf16(st[2 * kstep + 1][0], st[2 * kstep + 1][1]); pw.w = pg8::cvt_pk_bf16(st[2 * kstep + 1][2], st[2 * kstep + 1][3]);
                const bf16x8 pf = __builtin_bit_cast(bf16x8, pw);
#pragma unroll
                for (int db = 0; db < 16; ++db) o[db] = __builtin_amdgcn_mfma_f32_16x16x32_bf16(lfp[4096 + ((kstep - 4) * 16 + db) * 64], pf, o[db], 0, 0, 0);
            }
            XA_BAR();
            { LAS unsigned char* sw_ = ring + w * 8192 + ql * 512 + (g & 1) * 8;
#pragma unroll
              for (int db = 0; db < 16; ++db)
                  *(LAS unsigned long long*)(sw_ + (((2 * db + (g >> 1)) ^ ql) << 4)) = (unsigned long long)pg8::cvt_pk_bf16(o[db][0] * inv, o[db][1] * inv) | ((unsigned long long)pg8::cvt_pk_bf16(o[db][2] * inv, o[db][3] * inv) << 32);
              const int le = launder_i(lane), rr = le >> 5, cc = le & 31;
              bf16_t* op = O + ((size_t)b * SEQ + qb * 128 + w * 16 + rr) * XA_WIDTH + hd * XA_HD + cc * 8;
#pragma unroll
              for (int i = 0; i < 8; ++i) { const int r_ = 2 * i + rr; const u32x4 v_ = *(const LAS u32x4*)(ring + w * 8192 + r_ * 512 + ((cc ^ r_) << 4)); store16_wt(op + (size_t)(2 * i) * XA_WIDTH, v_); } }
            asm volatile("s_waitcnt vmcnt(0)" ::: "memory");
        }
#undef XA_WAIT_V
#undef XA_BAR
#undef XA_STAGE
    }
    PHASE_END_NOBAR()
    {
        const int c = (int)blockIdx.x;
        unsigned* f6 = (unsigned*)(ws + WS_CTL) + CW_F6;
        handoff_signal(f6 + (4 * (c & 7) + (c >> 6)) * 16);
        const int pm0 = 4 * ((c & 7) >> 1) + (c >> 6);
        handoff_wait2(f6 + pm0 * 16, 8u, f6 + (16 + pm0) * 16, 8u, (unsigned*)(ws + WS_CTL) + CW_BAR);
    }

    PHASE_BEGIN(9)
    {
        PanelSched S; S.A = (const char*)O; S.B = (const char*)WxoT; S.a_tile = (size_t)256 * XA_WIDTH * 2; S.b_tile = (size_t)256 * XA_WIDTH * 2; S.G = F.G; S.c = (int)blockIdx.x; S.perm = 0;
        EpiOut E; E.out = out; E.X1b = X1b; E.g = g_xa_post; E.rss = (float*)(ws + WS_CTL) + CW_RSS3; E.cnt = (unsigned*)(ws + WS_CTL) + CW_CNT3; E.xl = (LAS float*)(F.lds + XCH_OFF);
        pg8::Geom g; g.K = XA_WIDTH; g.lda = XA_WIDTH; g.ldb = XA_WIDTH;
        pg8::gemm_phase(F.lds + RING_OFF, g, S, E);
    }
    PHASE_END_NOBAR()
}

extern "C" void kernel_launch(void* const* d_in, const int* in_sizes, int n_in, void* d_out, int out_size, void* d_ws, size_t ws_size, hipStream_t stream) {
    static int grid = 0;
    if (grid == 0) {
        if (n_in != 16 || in_sizes[0] != NTOK * D_MODEL || out_size != NTOK * D_MODEL || ws_size < WS_END) { fprintf(stderr, "kernel_launch: unexpected shapes (n_in %d, ws %zu)\n", n_in, ws_size); grid = -1; return; }
        int dev = 0, cus = 0, per_cu = 0;
        if (hipGetDevice(&dev) != hipSuccess || hipDeviceGetAttribute(&cus, hipDeviceAttributeMultiprocessorCount, dev) != hipSuccess) { grid = -1; return; }
        if (hipFuncSetAttribute((const void*)mk_fwd, hipFuncAttributeMaxDynamicSharedMemorySize, LDS_BYTES) != hipSuccess) { fprintf(stderr, "kernel_launch: hipFuncSetAttribute failed\n"); grid = -1; return; }
        if (hipOccupancyMaxActiveBlocksPerMultiprocessor(&per_cu, (const void*)mk_fwd, NWAVES * 64, LDS_BYTES) != hipSuccess || per_cu < 1) { fprintf(stderr, "kernel_launch: occupancy query says %d workgroups per CU\n", per_cu); (void)hipGetLastError(); grid = -1; return; }
        if (cus != 256) { fprintf(stderr, "kernel_launch: built for a 256-CU device (got %d CUs)\n", cus); grid = -1; return; }
        grid = cus;
    }
    if (grid < 0) return;
    if (hipMemsetAsync((char*)d_ws + WS_CTL, 0, CTL_ZERO_BYTES, stream) != hipSuccess) return;
    Args a{};
    for (int i = 0; i < 16; ++i) a.in[i] = (const float*)d_in[i];
    a.out = (float*)d_out; a.ws = (unsigned char*)d_ws;
    hipLaunchKernelGGL(mk_fwd, dim3(grid), dim3(NWAVES * 64), LDS_BYTES, stream, a);
}
```
